# Optimizing an MI355X kernel written in HIP

```python
import jax, jax.numpy as jnp
from jax import lax
import numpy as np

D_MODEL = 1024
BATCH = 8
SEQ = 2048
DEPTH = 1
DEC_BATCH = 128
DEC_SEQ = 1
PAST_LEN = 16384
PAGE_SIZE = 128

POOL_WINDOWS = (2, 4, 8, 16)
N_POOL_GROUPS = len(POOL_WINDOWS)
POOL_WIDTH = D_MODEL // 2
POOL_GROUP = POOL_WIDTH // N_POOL_GROUPS
POOL_STATE = max(POOL_WINDOWS) - 1
GMLP_WIDTH = D_MODEL // 2
N_GMLP_GROUPS = 4
GMLP_GROUP = GMLP_WIDTH // N_GMLP_GROUPS
CHUNK = 128
D_FF = -(-8 * D_MODEL // (3 * 256)) * 256
IN_WIDTH = POOL_WIDTH + 2 * GMLP_WIDTH + 2 * D_MODEL
EPS = 1e-6

kernel_name = "pool_gmlp_gated_hybrid_step"


def rmsnorm(x, g):
    xf = x.astype(jnp.float32)
    y = xf * lax.rsqrt(jnp.mean(xf * xf, axis=-1, keepdims=True) + EPS)
    return (y * g.astype(jnp.float32)).astype(x.dtype)


def pool_mixer(a, pos0, w_pool, s_pool):
    B, T, _ = a.shape
    af = a.astype(jnp.float32)
    pos = pos0 + jnp.arange(T)
    outs = []
    for gi, w in enumerate(POOL_WINDOWS):
        xg = af[..., gi * POOL_GROUP:(gi + 1) * POOL_GROUP]
        cs = jnp.cumsum(jnp.pad(xg, ((0, 0), (w, 0), (0, 0))), axis=1)
        wsum = cs[:, w:] - cs[:, :T]
        cnt = jnp.minimum(w, pos + 1).astype(jnp.float32)[None, :, None]
        outs.append(wsum / cnt - xg)
    p = jnp.stack(outs, axis=2).astype(a.dtype)
    p = jnp.einsum('btgc,gcd->btgd', p, w_pool)
    return p.reshape(B, T, POOL_WIDTH) * s_pool


def spatial_gating(z, w_s, b_s, g_v):
    B, T, _ = z.shape
    u = z[..., :GMLP_WIDTH]
    v = rmsnorm(z[..., GMLP_WIDTH:], g_v)
    pad = (-T) % CHUNK
    nc = (T + pad) // CHUNK
    vc = jnp.pad(v, ((0, 0), (0, pad), (0, 0))).reshape(B, nc, CHUNK, N_GMLP_GROUPS, GMLP_GROUP)
    mask = jnp.tril(jnp.ones((CHUNK, CHUNK), dtype=bool))
    w = jnp.where(mask[None], w_s, jnp.zeros_like(w_s))
    s = jnp.einsum('gij,bnjgc->bnigc', w, vc) + jnp.transpose(b_s)[None, None, :, :, None]
    s = s.reshape(B, nc * CHUNK, GMLP_WIDTH)[:, :T]
    return u * s, v


def layer(x, pool_prev, w_in, g_mix, w_pool, s_pool, w_s, b_s, g_v,
          w_pool_out, w_gmlp_out, w_out, g_ffn, w_gate, w_up, w_down):
    T = x.shape[1]
    h = rmsnorm(x, g_mix)
    proj = h @ w_in
    o1 = POOL_WIDTH
    o2 = o1 + 2 * GMLP_WIDTH
    o3 = o2 + D_MODEL
    a = proj[..., :o1]
    z = jax.nn.gelu(proj[..., o1:o2])
    gate_a = jax.nn.sigmoid(proj[..., o2:o3])
    gate_b = jax.nn.sigmoid(proj[..., o3:])
    if pool_prev is None:
        seq_a, pos0 = a, 0
    else:
        seq_a, pos0 = jnp.concatenate([pool_prev.astype(a.dtype), a], axis=1), PAST_LEN - POOL_STATE
    pa = pool_mixer(seq_a, pos0, w_pool, s_pool)[:, -T:]
    new_pool = seq_a[:, -POOL_STATE:]
    sg, v = spatial_gating(z, w_s, b_s, g_v)
    merged = gate_a * (pa @ w_pool_out) + gate_b * (sg @ w_gmlp_out)
    x = x + merged @ w_out
    h2 = rmsnorm(x, g_ffn)
    x = x + (jax.nn.silu(h2 @ w_gate) * (h2 @ w_up)) @ w_down
    return x, new_pool, v


def setup_inputs(seed: int = 0) -> dict:
    key = jax.random.key(seed)
    ks = jax.random.split(key, 20)
    f32 = jnp.float32

    def nrm(k, shape, scale):
        return jax.random.normal(k, shape, f32) * scale

    def gain(k, shape):
        return 1.0 + 0.02 * jax.random.normal(k, shape, f32)

    return {
        "x_prompt": nrm(ks[0], (BATCH, SEQ, D_MODEL), 1.0),
        "x_sample": nrm(ks[1], (DEC_BATCH, DEC_SEQ, D_MODEL), 1.0),
        "state_pool": nrm(ks[2], (DEPTH, DEC_BATCH, POOL_STATE, POOL_WIDTH), 1.0),
        "w_in": nrm(ks[3], (DEPTH, D_MODEL, IN_WIDTH), D_MODEL ** -0.5),
        "g_mix": gain(ks[4], (DEPTH, D_MODEL)),
        "w_pool": nrm(ks[5], (DEPTH, N_POOL_GROUPS, POOL_GROUP, POOL_GROUP), POOL_GROUP ** -0.5),
        "s_pool": gain(ks[6], (DEPTH, POOL_WIDTH)),
        "w_s": nrm(ks[7], (DEPTH, N_GMLP_GROUPS, CHUNK, CHUNK), CHUNK ** -0.5),
        "b_s": gain(ks[8], (DEPTH, N_GMLP_GROUPS, CHUNK)),
        "g_v": gain(ks[9], (DEPTH, GMLP_WIDTH)),
        "w_pool_out": nrm(ks[10], (DEPTH, POOL_WIDTH, D_MODEL), POOL_WIDTH ** -0.5),
        "w_gmlp_out": nrm(ks[11], (DEPTH, GMLP_WIDTH, D_MODEL), GMLP_WIDTH ** -0.5),
        "w_out": nrm(ks[12], (DEPTH, D_MODEL, D_MODEL), D_MODEL ** -0.5),
        "g_ffn": gain(ks[13], (DEPTH, D_MODEL)),
        "w_gate": nrm(ks[14], (DEPTH, D_MODEL, D_FF), D_MODEL ** -0.5),
        "w_up": nrm(ks[15], (DEPTH, D_MODEL, D_FF), D_MODEL ** -0.5),
        "w_down": nrm(ks[16], (DEPTH, D_FF, D_MODEL), D_FF ** -0.5),
        "g_final": gain(ks[17], (D_MODEL,)),
    }


def reference(x_prompt, x_sample, state_pool, w_in, g_mix, w_pool, s_pool, w_s, b_s, g_v,
              w_pool_out, w_gmlp_out, w_out, g_ffn, w_gate, w_up, w_down, g_final):
    xp, xs = x_prompt, x_sample
    pools_p, pools_s, vs_s = [], [], []
    for l in range(DEPTH):
        params = (w_in[l], g_mix[l], w_pool[l], s_pool[l], w_s[l], b_s[l], g_v[l],
                  w_pool_out[l], w_gmlp_out[l], w_out[l], g_ffn[l], w_gate[l], w_up[l], w_down[l])
        xp, pool_p, _ = layer(xp, None, *params)
        xs, pool_s, v_s = layer(xs, state_pool[l], *params)
        pools_p.append(pool_p)
        pools_s.append(pool_s)
        vs_s.append(v_s)
    y_prompt = rmsnorm(xp, g_final)
    y_sample = rmsnorm(xs, g_final)
    new_pool_prompt = jnp.stack(pools_p, axis=0)
    new_pool_sample = jnp.stack(pools_s, axis=0)
    new_v_sample = jnp.stack(vs_s, axis=0)
    return (y_prompt, y_sample, new_pool_prompt, new_pool_sample, new_v_sample)
```

```cpp
#include <hip/hip_runtime.h>
#include <cstdio>
#include <cstdint>

#ifndef MK_N_LAUNCHES
#define MK_N_LAUNCHES 1
#endif

#define LAS __attribute__((address_space(3)))
#define GAS __attribute__((address_space(1)))
typedef unsigned short bf16_t;
typedef short bf16x8 __attribute__((ext_vector_type(8)));
typedef float f32x4 __attribute__((ext_vector_type(4)));
typedef float f32x2 __attribute__((ext_vector_type(2)));
typedef unsigned u32x4 __attribute__((ext_vector_type(4)));
typedef unsigned u32x2 __attribute__((ext_vector_type(2)));

constexpr int D = 1024, SEQ = 2048, NB = 8, M = NB * SEQ, NS = 128, PW = 512, GWID = 512, DFF = 2816, INW = 3584, PST = 15;
constexpr float EPS = 1e-6f;
constexpr size_t O_YP = 0, O_YS = (size_t)M * D, O_PP = O_YS + (size_t)NS * D, O_PS = O_PP + (size_t)NB * PST * PW, O_VS = O_PS + (size_t)NS * PST * PW;

constexpr size_t MiB = 1u << 20, KiB = 1u << 10;
constexpr size_t WS_CTL = 0, CTL_ZERO_BYTES = 64 * KiB;
constexpr size_t WS_WIN = 1 * MiB, WS_WGO = 8 * MiB, WS_WPO = 9 * MiB, WS_WOUT = 10 * MiB, WS_WGU = 12 * MiB, WS_WD = 23 * MiB;
constexpr size_t WS_WPT = 29 * MiB, WS_WST = 29 * MiB + 128 * KiB;
constexpr size_t WS_VSSQ = 30 * MiB, WS_XSSQ = 30 * MiB + 512 * KiB;
constexpr size_t WS_H = 32 * MiB, WS_MERGED = 32 * MiB;
constexpr size_t WS_A = 64 * MiB, WS_ZU = 80 * MiB, WS_X1B = 64 * MiB;
constexpr size_t WS_ZV = 96 * MiB, WS_GA = 112 * MiB, WS_GB = 144 * MiB, WS_ACT = 96 * MiB;
constexpr size_t WS_PA = 184 * MiB, WS_SG = 200 * MiB;
constexpr size_t WS_S = 216 * MiB;
constexpr size_t WS_HS = WS_S, WS_PROJS = WS_S + 256 * KiB, WS_PAS = WS_S + 2304 * KiB, WS_SGS = WS_S + 2432 * KiB,
                 WS_MERGEDS = WS_S + 2560 * KiB, WS_X1SB = WS_S + 2816 * KiB, WS_SSQS = WS_S + 3072 * KiB, WS_ACTS = WS_S + 3200 * KiB;
constexpr size_t WS_END = 224 * MiB;
constexpr int CW_BAR = 1024;

constexpr int NWAVES = 8;
constexpr int RING_BYTES = 131072, LDSCTL_OFF = RING_BYTES, MISC_OFF = LDSCTL_OFF + 320, LDS_BYTES = 147456;

__device__ __forceinline__ unsigned cvt_pk_bf16(float lo, float hi) { unsigned r; asm volatile("v_cvt_pk_bf16_f32 %0, %1, %2" : "=v"(r) : "v"(lo), "v"(hi)); return r; }
__device__ __forceinline__ float bf_lo(unsigned w) { return __uint_as_float(w << 16); }
__device__ __forceinline__ float bf_hi(unsigned w) { return __uint_as_float(w & 0xffff0000u); }
__device__ __forceinline__ float bf2f(bf16_t b) { return __uint_as_float(((unsigned)b) << 16); }
__device__ __forceinline__ bf16_t f2bf(float f) { return (bf16_t)(cvt_pk_bf16(f, 0.f) & 0xffffu); }
__device__ __forceinline__ float sigmoid_f(float x) { return __builtin_amdgcn_rcpf(1.f + __builtin_amdgcn_exp2f(-1.4426950408889634f * x)); }
__device__ __forceinline__ float gelu_f(float x) { const float u = x * (1.f + 0.044715f * x * x); return x * __builtin_amdgcn_rcpf(1.f + __builtin_amdgcn_exp2f(-2.3022081986f * u)); }
__device__ __forceinline__ float wave_sum(float v) {
#pragma unroll
    for (int o = 1; o < 64; o <<= 1) v += __shfl_xor(v, o);
    return v;
}

namespace pg8 {
constexpr int BM = 256, BK = 64, HALF = 128, HTB = HALF * BK * 2, STAGE_BYTES = 8 * HTB, NXCD = 8, WGM = 8;
__host__ __device__ __forceinline__ int lds_byte(int r, int c) { const int st = (r >> 4) * 2 + (c >> 5), rr = r & 15, cc = c & 31, ob = rr * 64 + cc * 2; return st * 1024 + (ob ^ (((ob >> 9) & 1) << 5)); }
__host__ __device__ __forceinline__ void stage_rc(int b, int& R, int& C) { const int st = b / 1024, sb = b % 1024, swz = sb ^ (((sb >> 9) & 1) << 5); R = (st >> 1) * 16 + swz / 64; C = (st & 1) * 32 + (swz % 64) / 2; }
__host__ __device__ __forceinline__ int perm32(int rho) { const int n = rho >> 4, i = rho & 15; return 8 * (i >> 2) + 4 * n + (i & 3); }

struct Unit { int pm, pn, part; };
struct Gemm { const bf16_t* A0; const bf16_t* A1; const bf16_t* B0; const bf16_t* B1; int K; };

struct StaticOrder {
    int nM, nN, nwg, G, c, NP;
    __host__ __device__ void init(int M_, int N_, int G_, int c_, int NP_) { nM = M_ / BM; nN = N_ / BM; nwg = nM * nN; G = G_; c = c_; NP = NP_; }
    __host__ __device__ bool next(int i, Unit& u) const {
        const int ii = i / NP; u.part = i - ii * NP;
        const long L = (long)ii * G + c; if (L >= nwg) return false;
        int wgid = (int)L; { const int q = nwg / NXCD, r = nwg % NXCD, xcd = wgid % NXCD, off = wgid / NXCD; wgid = (xcd < r ? xcd * (q + 1) : r * (q + 1) + (xcd - r) * q) + off; }
        const int nig = WGM * nN, gid = wgid / nig, fm = gid * WGM, gsz = (nM - fm) < WGM ? (nM - fm) : WGM;
        u.pm = fm + ((wgid % nig) % gsz); u.pn = (wgid % nig) / gsz; return true;
    }
};

typedef f32x4 Acc[2][2][4][2];

struct EpiProj {
    static constexpr bool PERM = true;
    bf16_t *a, *zu, *zv, *ga, *gb; float* vssq; float* pool_out;
    __device__ __forceinline__ bool keep(const Unit&) const { return false; }
    __device__ __forceinline__ void operator()(Acc& acc, const Unit& u, int wr, int wc, int fr, int fq) const {
        const int pn = u.pn; int kind, ldc, colt; bf16_t* base;
        if (pn < 2) { kind = 0; base = a; ldc = 512; colt = pn * 256; }
        else if (pn < 4) { kind = 1; base = zu; ldc = 512; colt = (pn - 2) * 256; }
        else if (pn < 6) { kind = 2; base = zv; ldc = 512; colt = (pn - 4) * 256; }
        else if (pn < 10) { kind = 3; base = ga; ldc = 1024; colt = (pn - 6) * 256; }
        else { kind = 3; base = gb; ldc = 1024; colt = (pn - 10) * 256; }
        const int row0 = u.pm * BM + wr * 64 + fr, col0 = colt + wc * 32 + 8 * fq;
        const bool poolpanel = (kind == 0) && ((u.pm & 7) == 7);
#pragma unroll
        for (int ai = 0; ai < 2; ++ai)
#pragma unroll
            for (int m = 0; m < 4; ++m) {
                const int row = row0 + ai * HALF + m * 16; bf16_t* rowp = base + (size_t)row * ldc + col0; float ss = 0.f;
#pragma unroll
                for (int bj = 0; bj < 2; ++bj) {
                    f32x4 v0 = acc[ai][bj][m][0], v1 = acc[ai][bj][m][1];
                    if (kind == 1 || kind == 2) {
#pragma unroll
                        for (int i = 0; i < 4; ++i) { v0[i] = gelu_f(v0[i]); v1[i] = gelu_f(v1[i]); }
                        if (kind == 2) ss += (v0[0] * v0[0] + v0[1] * v0[1]) + (v0[2] * v0[2] + v0[3] * v0[3]) + (v1[0] * v1[0] + v1[1] * v1[1]) + (v1[2] * v1[2] + v1[3] * v1[3]);
                    } else if (kind == 3) {
#pragma unroll
                        for (int i = 0; i < 4; ++i) { v0[i] = sigmoid_f(v0[i]); v1[i] = sigmoid_f(v1[i]); }
                    }
                    u32x4 w; w.x = cvt_pk_bf16(v0[0], v0[1]); w.y = cvt_pk_bf16(v0[2], v0[3]); w.z = cvt_pk_bf16(v1[0], v1[1]); w.w = cvt_pk_bf16(v1[2], v1[3]);
                    *(u32x4*)(rowp + bj * HALF) = w;
                    if (poolpanel && ai == 1) {
                        const int tl = 1792 + 128 + wr * 64 + m * 16 + fr;
                        if (tl >= SEQ - PST) { float* pp = pool_out + ((size_t)((u.pm >> 3) * PST + tl - (SEQ - PST))) * PW + col0 + bj * HALF; *(f32x4*)pp = v0; *(f32x4*)(pp + 4) = v1; }
                    }
                }
                if (kind == 2) { ss += __shfl_xor(ss, 16); ss += __shfl_xor(ss, 32); if (fq == 0) vssq[(size_t)row * 8 + (pn - 4) * 4 + wc] = ss; }
            }
    }
};
struct EpiMerge {
    static constexpr bool PERM = true;
    const bf16_t *ga, *gb; bf16_t* out;
    __device__ __forceinline__ bool keep(const Unit& u) const { return u.part == 0; }
    __device__ __forceinline__ void operator()(Acc& acc, const Unit& u, int wr, int wc, int fr, int fq) const {
        const int row0 = u.pm * BM + wr * 64 + fr, col0 = u.pn * BM + wc * 32 + 8 * fq;
#pragma unroll
        for (int ai = 0; ai < 2; ++ai)
#pragma unroll
            for (int m = 0; m < 4; ++m) {
#pragma unroll
                for (int bj = 0; bj < 2; ++bj) {
                    const size_t off = (size_t)(row0 + ai * HALF + m * 16) * D + col0 + bj * HALF;
                    const u32x4 g1 = *(const u32x4*)(ga + off);
                    float a8[8] = {bf_lo(g1.x), bf_hi(g1.x), bf_lo(g1.y), bf_hi(g1.y), bf_lo(g1.z), bf_hi(g1.z), bf_lo(g1.w), bf_hi(g1.w)};
                    if (u.part == 0) {
                        const u32x4 g2 = *(const u32x4*)(gb + off);
                        const float b8[8] = {bf_lo(g2.x), bf_hi(g2.x), bf_lo(g2.y), bf_hi(g2.y), bf_lo(g2.z), bf_hi(g2.z), bf_lo(g2.w), bf_hi(g2.w)};
#pragma unroll
                        for (int i = 0; i < 4; ++i) { acc[ai][bj][m][0][i] *= b8[i] * __builtin_amdgcn_rcpf(fmaxf(a8[i], 1e-30f)); acc[ai][bj][m][1][i] *= b8[4 + i] * __builtin_amdgcn_rcpf(fmaxf(a8[4 + i], 1e-30f)); }
                    } else {
                        const f32x4 v0 = acc[ai][bj][m][0], v1 = acc[ai][bj][m][1];
                        u32x4 w; w.x = cvt_pk_bf16(v0[0] * a8[0], v0[1] * a8[1]); w.y = cvt_pk_bf16(v0[2] * a8[2], v0[3] * a8[3]); w.z = cvt_pk_bf16(v1[0] * a8[4], v1[1] * a8[5]); w.w = cvt_pk_bf16(v1[2] * a8[6], v1[3] * a8[7]);
                        *(u32x4*)(out + off) = w;
                    }
                }
                if (m & 1) asm volatile("" ::: "memory");
            }
    }
};
struct EpiWout {
    static constexpr bool PERM = false;
    const float* x; float* x1; bf16_t* x1b; float* xssq;
    __device__ __forceinline__ bool keep(const Unit&) const { return false; }
    __device__ __forceinline__ void operator()(Acc& acc, const Unit& u, int wr, int wc, int fr, int fq) const {
        const int col0 = u.pn * BM + wc * 32 + 4 * fq;
#pragma unroll
        for (int ai = 0; ai < 2; ++ai)
#pragma unroll
            for (int m = 0; m < 4; ++m) {
                const int r = u.pm * BM + ai * HALF + wr * 64 + m * 16 + fr; const size_t off = (size_t)r * D + col0; float ss = 0.f;
#pragma unroll
                for (int bj = 0; bj < 2; ++bj)
#pragma unroll
                    for (int n = 0; n < 2; ++n) {
                        const f32x4 o = *(const f32x4*)(x + off + bj * HALF + n * 16) + acc[ai][bj][m][n];
                        *(f32x4*)(x1 + off + bj * HALF + n * 16) = o;
                        u32x2 w; w.x = cvt_pk_bf16(o[0], o[1]); w.y = cvt_pk_bf16(o[2], o[3]); *(u32x2*)(x1b + off + bj * HALF + n * 16) = w;
                        ss += (o[0] * o[0] + o[1] * o[1]) + (o[2] * o[2] + o[3] * o[3]);
                    }
                ss += __shfl_xor(ss, 16); ss += __shfl_xor(ss, 32);
                if (fq == 0) xssq[(size_t)r * 16 + u.pn * 4 + wc] = ss;
                if (m & 1) asm volatile("" ::: "memory");
            }
    }
};
struct EpiGU {
    static constexpr bool PERM = true;
    const float* xssq; bf16_t* act;
    __device__ __forceinline__ bool keep(const Unit&) const { return false; }
    __device__ __forceinline__ void operator()(Acc& acc, const Unit& u, int wr, int wc, int fr, int fq) const {
        const int row0 = u.pm * BM + wr * 64 + fr, col0 = u.pn * HALF + wc * 32 + 8 * fq;
#pragma unroll
        for (int ai = 0; ai < 2; ++ai)
#pragma unroll
            for (int m = 0; m < 4; ++m) {
                const int row = row0 + ai * HALF + m * 16; const f32x4* sp = (const f32x4*)(xssq + (size_t)row * 16);
                const f32x4 s4 = (sp[0] + sp[1]) + (sp[2] + sp[3]); const float r = rsqrtf(((s4[0] + s4[1]) + (s4[2] + s4[3])) * (1.f / D) + EPS);
                float o[8];
#pragma unroll
                for (int n = 0; n < 2; ++n)
#pragma unroll
                    for (int i = 0; i < 4; ++i) { const float g = acc[ai][0][m][n][i] * r, uu = acc[ai][1][m][n][i] * r; o[n * 4 + i] = g * sigmoid_f(g) * uu; }
                u32x4 w; w.x = cvt_pk_bf16(o[0], o[1]); w.y = cvt_pk_bf16(o[2], o[3]); w.z = cvt_pk_bf16(o[4], o[5]); w.w = cvt_pk_bf16(o[6], o[7]);
                *(u32x4*)(act + (size_t)row * DFF + col0) = w;
                if (m & 1) asm volatile("" ::: "memory");
            }
    }
};
struct EpiDown {
    static constexpr bool PERM = false;
    float* x1;
    __device__ __forceinline__ bool keep(const Unit&) const { return false; }
    __device__ __forceinline__ void operator()(Acc& acc, const Unit& u, int wr, int wc, int fr, int fq) const {
        const int col0 = u.pn * BM + wc * 32 + 4 * fq;
#pragma unroll
        for (int ai = 0; ai < 2; ++ai)
#pragma unroll
            for (int m = 0; m < 4; ++m) {
                const int r = u.pm * BM + ai * HALF + wr * 64 + m * 16 + fr; const size_t off = (size_t)r * D + col0;
#pragma unroll
                for (int bj = 0; bj < 2; ++bj)
#pragma unroll
                    for (int n = 0; n < 2; ++n) { float* p = x1 + off + bj * HALF + n * 16; *(f32x4*)p = *(const f32x4*)p + acc[ai][bj][m][n]; }
                if (m & 1) asm volatile("" ::: "memory");
            }
    }
};

template <class Epi, bool ALIGN_EPI>
__device__ __forceinline__ void gemm_phase(LAS unsigned char* lds, const Gemm g, const StaticOrder& S, const Epi& E) {
    const int tid = threadIdx.x, wid = __builtin_amdgcn_readfirstlane(tid >> 6), lane = tid & 63, wr = wid >> 2, wc = wid & 3, fr = lane & 15, fq = lane >> 4;
    const int K = g.K, nt = K / BK;
    unsigned voffA[2], voffB[2];
#pragma unroll
    for (int i = 0; i < 2; ++i) { int R, C; stage_rc(tid * 16 + i * 8192, R, C); const int Rb = Epi::PERM ? ((R & ~31) + perm32(R & 31)) : R;
        voffA[i] = (unsigned)(R * K + C) * 2u; voffB[i] = (unsigned)(Rb * K + C) * 2u; }
    const size_t kstep = (size_t)(BK * 2);
    const size_t hstep = (size_t)HALF * K * 2;
    const size_t tstep = 2 * hstep;
    const unsigned ldsw = (unsigned)wid * 1024u;
    const int aoff = lds_byte(wr * 64 + fr, fq * 8), boff = lds_byte(wc * 32 + fr, fq * 8);
#define PG8_SA(b, h) (((b) * 2 + (h)) * HTB)
#define PG8_SB(b, h) ((4 + (b) * 2 + (h)) * HTB)
#define PG8_STAGE(bufoff, gbase, voff) do { _Pragma("unroll") for (int _i = 0; _i < 2; ++_i) \
        __builtin_amdgcn_global_load_lds((const unsigned*)((const char*)(gbase) + (voff)[_i]), (LAS unsigned*)(lds + (bufoff) + ldsw + _i * 8192), 16, 0, 0); } while (0)
#define PG8_LDA(dst, b, h) do { _Pragma("unroll") for (int m = 0; m < 4; ++m) _Pragma("unroll") for (int k = 0; k < 2; ++k) dst[m][k] = *(const LAS bf16x8*)(lds + PG8_SA(b, h) + aoff + m * 2048 + k * 1024); } while (0)
#define PG8_LDB(dst, b, h) do { _Pragma("unroll") for (int n = 0; n < 2; ++n) _Pragma("unroll") for (int k = 0; k < 2; ++k) dst[n][k] = *(const LAS bf16x8*)(lds + PG8_SB(b, h) + boff + n * 2048 + k * 1024); } while (0)
#define PG8_MMA(ai, bj, At, Bt) do { __builtin_amdgcn_s_setprio(1); _Pragma("unroll") for (int m = 0; m < 4; ++m) _Pragma("unroll") for (int n = 0; n < 2; ++n) _Pragma("unroll") for (int k = 0; k < 2; ++k) \
        acc[ai][bj][m][n] = __builtin_amdgcn_mfma_f32_16x16x32_bf16(Bt[n][k], At[m][k], acc[ai][bj][m][n], 0, 0, 0); __builtin_amdgcn_s_setprio(0); } while (0)
#define PG8_WAIT_V(n) asm volatile("s_waitcnt vmcnt(" #n ")" ::: "memory")
#define PG8_WAIT_L(n) asm volatile("s_waitcnt lgkmcnt(" #n ")" ::: "memory")
#define PG8_BAR __builtin_amdgcn_s_barrier()
#define PG8_SCHED __builtin_amdgcn_sched_barrier(0)
#define PG8_APTR(u) ((const char*)((u).part ? g.A1 : g.A0) + (size_t)(u).pm * tstep)
#define PG8_BPTR(u) ((const char*)((u).part ? g.B1 : g.B0) + (size_t)(u).pn * tstep)
    Unit cur, nxt; int ui = 0;
    if (!S.next(0, cur)) return;
    Acc acc;
#pragma unroll
    for (int a = 0; a < 2; ++a)
#pragma unroll
        for (int b = 0; b < 2; ++b)
#pragma unroll
            for (int m = 0; m < 4; ++m)
#pragma unroll
                for (int n = 0; n < 2; ++n) acc[a][b][m][n] = (f32x4){0.f, 0.f, 0.f, 0.f};
    bf16x8 At[4][2], B0[2][2], B1[2][2];
    const char* cA = PG8_APTR(cur); const char* cB = PG8_BPTR(cur);
    PG8_STAGE(PG8_SB(0, 0), cB, voffB); PG8_STAGE(PG8_SB(0, 1), cB + hstep, voffB); PG8_STAGE(PG8_SA(0, 0), cA, voffA); PG8_STAGE(PG8_SA(0, 1), cA + hstep, voffA);
    if (wr == 1) PG8_BAR;
    PG8_WAIT_V(2); PG8_BAR;
    PG8_STAGE(PG8_SB(1, 0), cB + kstep, voffB); PG8_STAGE(PG8_SA(1, 0), cA + kstep, voffA); PG8_STAGE(PG8_SB(1, 1), cB + hstep + kstep, voffB);
    PG8_WAIT_V(6); PG8_BAR;
    for (;;) {
        const bool has_next = S.next(ui + 1, nxt);
        const char* nA = has_next ? PG8_APTR(nxt) : cA; const char* nB = has_next ? PG8_BPTR(nxt) : cB;
        for (int t = 0; t < nt; t += 2) {
            const bool last = (t == nt - 2);
            const char* a1 = cA + (size_t)(t + 1) * kstep;
            const char* a2 = last ? nA : cA + (size_t)(t + 2) * kstep; const char* b2 = last ? nB : cB + (size_t)(t + 2) * kstep;
            const char* a3 = a2 + kstep; const char* b3 = b2 + kstep;
            PG8_LDB(B0, 0, 0); PG8_LDB(B1, 0, 1); PG8_SCHED; PG8_LDA(At, 0, 0); PG8_STAGE(PG8_SA(1, 1), a1 + hstep, voffA);
            PG8_WAIT_V(8); PG8_WAIT_L(0); PG8_BAR; PG8_MMA(0, 0, At, B0); PG8_MMA(0, 1, At, B1); PG8_BAR; PG8_SCHED;
            PG8_LDA(At, 0, 1); PG8_STAGE(PG8_SB(0, 0), b2, voffB); PG8_STAGE(PG8_SB(0, 1), b2 + hstep, voffB); PG8_STAGE(PG8_SA(0, 0), a2, voffA);
            PG8_WAIT_V(8); PG8_WAIT_L(0); PG8_BAR; PG8_MMA(1, 0, At, B0); PG8_MMA(1, 1, At, B1); PG8_BAR; PG8_SCHED;
            PG8_LDB(B0, 1, 0); PG8_LDB(B1, 1, 1); PG8_SCHED; PG8_LDA(At, 1, 0); PG8_STAGE(PG8_SA(0, 1), a2 + hstep, voffA);
            PG8_WAIT_V(8); PG8_WAIT_L(0); PG8_BAR; PG8_MMA(0, 0, At, B0); PG8_MMA(0, 1, At, B1); PG8_BAR; PG8_SCHED;
            PG8_LDA(At, 1, 1); PG8_STAGE(PG8_SB(1, 0), b3, voffB); PG8_STAGE(PG8_SB(1, 1), b3 + hstep, voffB); PG8_STAGE(PG8_SA(1, 0), a3, voffA);
            PG8_WAIT_V(8); PG8_WAIT_L(0); PG8_BAR; PG8_MMA(1, 0, At, B0); PG8_MMA(1, 1, At, B1); PG8_BAR; PG8_SCHED;
        }
        if constexpr (ALIGN_EPI) { if (wr == 0) PG8_BAR; }
        E(acc, cur, wr, wc, fr, fq);
        if (!has_next) break;
        if (!E.keep(cur)) {
#pragma unroll
            for (int a = 0; a < 2; ++a)
#pragma unroll
                for (int b = 0; b < 2; ++b)
#pragma unroll
                    for (int m = 0; m < 4; ++m)
#pragma unroll
                        for (int n = 0; n < 2; ++n) acc[a][b][m][n] = (f32x4){0.f, 0.f, 0.f, 0.f};
        }
        cur = nxt; cA = nA; cB = nB; ++ui;
        if constexpr (ALIGN_EPI) { if (wr == 1) PG8_BAR; }
    }
    PG8_WAIT_V(0);
    if constexpr (!ALIGN_EPI) { if (wr == 0) PG8_BAR; }
    PG8_BAR;
#undef PG8_SA
#undef PG8_SB
#undef PG8_STAGE
#undef PG8_LDA
#undef PG8_LDB
#undef PG8_MMA
#undef PG8_WAIT_V
#undef PG8_WAIT_L
#undef PG8_BAR
#undef PG8_SCHED
#undef PG8_APTR
#undef PG8_BPTR
}
}

#define XB_TMO      128
#define XB_XCNT(j)  (256  + 64 * (j))
#define XB_XSUB(j)  (1280 + 64 * (j))
#define XB_XGEN(j)  (2304 + 64 * (j))
#define XB_TOP      3328
#define XB_TOPGEN   3392
#define XCD_BAR_WORDS 3456
#define XB_SPIN_CAP (1u << 18)
__device__ __forceinline__ unsigned xb_ld(unsigned* p)              { return __hip_atomic_load(p, __ATOMIC_RELAXED, __HIP_MEMORY_SCOPE_AGENT); }
__device__ __forceinline__ unsigned xb_add(unsigned* p, unsigned v) { return __hip_atomic_fetch_add(p, v, __ATOMIC_RELAXED, __HIP_MEMORY_SCOPE_AGENT); }
__device__ __forceinline__ unsigned xb_xcc_id() { return (unsigned)__builtin_amdgcn_s_getreg((3 << 11) | 20) & 0xFu; }
#define XB_SPIN(cond, bar) do { unsigned _sp = 0; while (cond) { __builtin_amdgcn_s_sleep(1); \
    if ((++_sp & 255u) == 0u) { if (xb_ld(&(bar)[XB_TMO])) break; if (_sp > XB_SPIN_CAP) { atomicAdd(&(bar)[XB_TMO], 1u); break; } } } } while (0)
struct XcdBarrier { unsigned* bar; unsigned x; volatile LAS unsigned* st; };
__device__ __forceinline__ XcdBarrier xcd_barrier_post(unsigned* bar, volatile LAS unsigned* st) {
    XcdBarrier b; b.bar = bar; b.x = xb_xcc_id(); b.st = st;
    if (threadIdx.x == 0) (void)xb_add(&bar[XB_XCNT(b.x)], 1u);
    return b;
}
__device__ __forceinline__ void xcd_barrier_complete(unsigned* bar, unsigned x, unsigned& nloc, unsigned& nx) {
    const unsigned G = gridDim.x * gridDim.y * gridDim.z;
    unsigned sum, cnt, mine, sp = 0u;
    for (;;) {
        sum = 0u; cnt = 0u; mine = 0u;
#pragma unroll
        for (unsigned j = 0; j < 16; ++j) { const unsigned c = xb_ld(&bar[XB_XCNT(j)]); sum += c; cnt += (c > 0u) ? 1u : 0u; mine = (j == x) ? c : mine; }
        if (sum == G) break;
        __builtin_amdgcn_s_sleep(1);
        if ((++sp & 255u) == 0u) { if (xb_ld(&bar[XB_TMO])) break; if (sp > XB_SPIN_CAP) { atomicAdd(&bar[XB_TMO], 1u); break; } }
    }
    nloc = mine > 0u ? mine : 1u; nx = cnt > 0u ? cnt : 1u;
}
__device__ __forceinline__ void xcd_barrier(const XcdBarrier& b) {
    asm volatile("s_waitcnt vmcnt(0)" ::: "memory");
    __syncthreads();
    if (threadIdx.x == 0) {
        unsigned* bar = b.bar;
        __builtin_amdgcn_s_waitcnt(0);
        unsigned nloc = b.st[0], nx = b.st[1];
        if (nloc == 0u) { xcd_barrier_complete(bar, b.x, nloc, nx); b.st[0] = nloc; b.st[1] = nx; }
        const unsigned old = xb_add(&bar[XB_XSUB(b.x)], 1u);
        const unsigned gen = old / nloc;
        if (old + 1u == (gen + 1u) * nloc) {
            __builtin_amdgcn_fence(__ATOMIC_RELEASE, "agent");
            asm volatile("s_waitcnt vmcnt(0)" ::: "memory");
            const unsigned og = xb_add(&bar[XB_TOP], 1u);
            const unsigned tg = og / nx;
            if (og + 1u == (tg + 1u) * nx) xb_add(&bar[XB_TOPGEN], 1u);
            else XB_SPIN(xb_ld(&bar[XB_TOPGEN]) == tg, bar);
            __builtin_amdgcn_fence(__ATOMIC_ACQUIRE, "agent");
            xb_add(&bar[XB_XGEN(b.x)], 1u);
            asm volatile("s_waitcnt vmcnt(0)" ::: "memory");
        } else {
            XB_SPIN(xb_ld(&bar[XB_XGEN(b.x)]) == gen, bar);
            __builtin_amdgcn_fence(__ATOMIC_ACQUIRE, "agent");
            asm volatile("s_waitcnt vmcnt(0)" ::: "memory");
        }
    }
    __syncthreads();
}

struct Args { const float* in[18]; float* out; unsigned char* ws; int ph_lo, ph_hi; };
enum { I_XP = 0, I_XS, I_STATE, I_WIN, I_GMIX, I_WPOOL, I_SPOOL, I_WS, I_BS, I_GV, I_WPO, I_WGO, I_WOUT, I_GFFN, I_WG, I_WU, I_WD, I_GFINAL };

__device__ __forceinline__ void tr_item(const float* W, int ldw, bf16_t* WT, int ldt, LAS float* scr, int k0, int n0, int drow0, int lane, const float* ks) {
#pragma unroll 8
    for (int i = 0; i < 32; ++i) { const int kk = 2 * i + (lane >> 5); float v = W[(size_t)(k0 + kk) * ldw + n0 + (lane & 31)]; if (ks) v *= ks[k0 + kk]; scr[kk * 33 + (lane & 31)] = v; }
    asm volatile("s_waitcnt lgkmcnt(0)" ::: "memory");
    const int c = lane & 7;
#pragma unroll
    for (int j = 0; j < 4; ++j) { const int n = (lane >> 3) + 8 * j; const LAS float* s = scr + (8 * c) * 33 + n;
        u32x4 o; o.x = cvt_pk_bf16(s[0 * 33], s[1 * 33]); o.y = cvt_pk_bf16(s[2 * 33], s[3 * 33]); o.z = cvt_pk_bf16(s[4 * 33], s[5 * 33]); o.w = cvt_pk_bf16(s[6 * 33], s[7 * 33]);
        *(u32x4*)(WT + (size_t)(drow0 + n) * ldt + k0 + 8 * c) = o; }
    asm volatile("s_waitcnt lgkmcnt(0)" ::: "memory");
}
__device__ __forceinline__ void norm_row_bf16(const float* xrow, const float* gain, bf16_t* orow, int lane) {
    const f32x4* xr = (const f32x4*)xrow + lane; const f32x4* gr = (const f32x4*)gain + lane;
    f32x4 v[4]; float s = 0.f;
#pragma unroll
    for (int j = 0; j < 4; ++j) { v[j] = xr[64 * j]; s += (v[j][0] * v[j][0] + v[j][1] * v[j][1]) + (v[j][2] * v[j][2] + v[j][3] * v[j][3]); }
    const float r = rsqrtf(wave_sum(s) * (1.f / D) + EPS);
    u32x2* o8 = (u32x2*)orow + lane;
#pragma unroll
    for (int j = 0; j < 4; ++j) { const f32x4 g = gr[64 * j]; u32x2 w; w.x = cvt_pk_bf16(v[j][0] * r * g[0], v[j][1] * r * g[1]); w.y = cvt_pk_bf16(v[j][2] * r * g[2], v[j][3] * r * g[3]); o8[64 * j] = w; }
}

template <int STEPS>
__device__ __forceinline__ void mini_acc(f32x4& acc0, f32x4& acc1, const bf16_t* A, int lda, const bf16_t* Bt, int ldb, int wave, int lane) {
    const int fr = lane & 15, fq = lane >> 4;
    const bf16_t* ap = A + (size_t)fr * lda + wave * (STEPS * 32) + 8 * fq;
    const bf16_t* bp = Bt + (size_t)fr * ldb + wave * (STEPS * 32) + 8 * fq;
    bf16x8 a0[STEPS], a1[STEPS], b[STEPS];
#pragma unroll
    for (int s = 0; s < STEPS; ++s) { a0[s] = *(const bf16x8*)(ap + 32 * s); a1[s] = *(const bf16x8*)(ap + (size_t)16 * lda + 32 * s); b[s] = *(const bf16x8*)(bp + 32 * s); }
#pragma unroll
    for (int s = 0; s < STEPS; ++s) { acc0 = __builtin_amdgcn_mfma_f32_16x16x32_bf16(b[s], a0[s], acc0, 0, 0, 0); acc1 = __builtin_amdgcn_mfma_f32_16x16x32_bf16(b[s], a1[s], acc1, 0, 0, 0); }
}
__device__ __forceinline__ float mini_reduce(LAS float* red, const f32x4& acc0, const f32x4& acc1, int tid, int wave, int lane) {
    *(LAS f32x4*)(red + (wave * 2 + 0) * 256 + lane * 4) = acc0; *(LAS f32x4*)(red + (wave * 2 + 1) * 256 + lane * 4) = acc1;
    __syncthreads();
    const int row = tid >> 4, col = tid & 15, h = row >> 4, lp = (col >> 2) * 16 + (row & 15), reg = col & 3;
    float s = 0.f;
#pragma unroll
    for (int w = 0; w < 8; ++w) s += red[(w * 2 + h) * 256 + lp * 4 + reg];
    __syncthreads();
    return s;
}

constexpr int PSTR = 136;
__device__ __forceinline__ void p2_pool_unit(LAS unsigned char* lds, int ch, int gi, const bf16_t* a, const bf16_t* WPT, const float* s_pool, bf16_t* pa, int tid, int wave, int lane) {
    LAS bf16_t* abuf = (LAS bf16_t*)lds;
    LAS bf16_t* pbuf = (LAS bf16_t*)(lds + 40960);
    const int m0 = ch * 128; const bool first = (ch & 15) == 0;
    for (int q = tid; q < 143 * 16; q += 512) { const int s = q >> 4, cq = q & 15;
        u32x4 v = (u32x4){0u, 0u, 0u, 0u}; if (!(first && s < 15)) v = *(const u32x4*)(a + (size_t)(m0 - 15 + s) * PW + gi * 128 + cq * 8);
        *(LAS u32x4*)(abuf + s * 128 + cq * 8) = v; }
    __syncthreads();
    {
        const int wnd = 2 << gi, c = tid & 127, t0 = (tid >> 7) * 32; float sum = 0.f;
        for (int s = t0 - wnd + 1; s < t0; ++s) sum += bf2f(abuf[(s + 15) * 128 + c]);
        const float inv = 1.f / (float)wnd;
        for (int t = t0; t < t0 + 32; ++t) {
            const float at = bf2f(abuf[(t + 15) * 128 + c]); sum += at;
            float mean = sum * inv; if (first && t + 1 < wnd) mean = sum / (float)(t + 1);
            pbuf[t * PSTR + c] = f2bf(mean - at);
            sum -= bf2f(abuf[(t + 16 - wnd) * 128 + c]);
        }
    }
    __syncthreads();
    {
        const int fr = lane & 15, fq = lane >> 4; bf16x8 wf[4];
#pragma unroll
        for (int ks = 0; ks < 4; ++ks) wf[ks] = *(const bf16x8*)(WPT + (size_t)gi * 16384 + (16 * wave + fr) * 128 + 32 * ks + 8 * fq);
        const f32x4 sp = *(const f32x4*)(s_pool + gi * 128 + 16 * wave + 4 * fq);
#pragma unroll
        for (int tt = 0; tt < 8; ++tt) {
            f32x4 acc = (f32x4){0.f, 0.f, 0.f, 0.f};
#pragma unroll
            for (int ks = 0; ks < 4; ++ks) { const bf16x8 pf = *(const LAS bf16x8*)(pbuf + (16 * tt + fr) * PSTR + 32 * ks + 8 * fq); acc = __builtin_amdgcn_mfma_f32_16x16x32_bf16(wf[ks], pf, acc, 0, 0, 0); }
            acc = acc * sp; u32x2 w; w.x = cvt_pk_bf16(acc[0], acc[1]); w.y = cvt_pk_bf16(acc[2], acc[3]);
            *(u32x2*)(pa + (size_t)(m0 + 16 * tt + fr) * PW + gi * 128 + 16 * wave + 4 * fq) = w;
        }
    }
    __syncthreads();
}
__device__ __forceinline__ void p2_gate_unit(LAS unsigned char* lds, int ch, int g, const bf16_t* zu, const bf16_t* zv, const float* vssq, const bf16_t* WST, const float* g_v, const float* b_s, bf16_t* sg,
                                             int tid, int wave, int lane) {
    LAS bf16_t* vT = (LAS bf16_t*)lds;
    LAS float* rbuf = (LAS float*)(lds + 40960);
    const int m0 = ch * 128;
    if (tid < 128) { const f32x4* sp = (const f32x4*)(vssq + (size_t)(m0 + tid) * 8); const f32x4 s4 = sp[0] + sp[1]; rbuf[tid] = rsqrtf(((s4[0] + s4[1]) + (s4[2] + s4[3])) * (1.f / GWID) + EPS); }
    __syncthreads();
#pragma unroll
    for (int it = 0; it < 4; ++it) {
        const int j = tid >> 2, chunk = (tid & 3) + 4 * it;
        const u32x4 raw = *(const u32x4*)(zv + (size_t)(m0 + j) * GWID + g * 128 + chunk * 8); const float r = rbuf[j];
        const float v8[8] = {bf_lo(raw.x), bf_hi(raw.x), bf_lo(raw.y), bf_hi(raw.y), bf_lo(raw.z), bf_hi(raw.z), bf_lo(raw.w), bf_hi(raw.w)};
#pragma unroll
        for (int i = 0; i < 8; ++i) vT[(chunk * 8 + i) * PSTR + j] = f2bf(v8[i] * r);
    }
    __syncthreads();
    {
        const int fr = lane & 15, fq = lane >> 4; bf16x8 wf[4];
#pragma unroll
        for (int ks = 0; ks < 4; ++ks) wf[ks] = *(const bf16x8*)(WST + (size_t)g * 16384 + (16 * wave + fr) * 128 + 32 * ks + 8 * fq);
        const int i = 16 * wave + fr; const float bias = b_s[g * 128 + i];
#pragma unroll
        for (int ct = 0; ct < 8; ++ct) {
            f32x4 acc = (f32x4){0.f, 0.f, 0.f, 0.f};
#pragma unroll
            for (int ks = 0; ks < 4; ++ks) { const bf16x8 vf = *(const LAS bf16x8*)(vT + (16 * ct + fr) * PSTR + 32 * ks + 8 * fq); acc = __builtin_amdgcn_mfma_f32_16x16x32_bf16(vf, wf[ks], acc, 0, 0, 0); }
            const int c = g * 128 + 16 * ct + 4 * fq; const f32x4 gv = *(const f32x4*)(g_v + c);
            const u32x2 uu = *(const u32x2*)(zu + (size_t)(m0 + i) * GWID + c);
            const f32x4 s = acc * gv + bias; u32x2 w; w.x = cvt_pk_bf16(bf_lo(uu.x) * s[0], bf_hi(uu.x) * s[1]); w.y = cvt_pk_bf16(bf_lo(uu.y) * s[2], bf_hi(uu.y) * s[3]);
            *(u32x2*)(sg + (size_t)(m0 + i) * GWID + c) = w;
        }
    }
    __syncthreads();
}

__global__ void __launch_bounds__(NWAVES * 64, 2) fwd_kernel(Args args) {
    extern __shared__ __attribute__((aligned(16))) unsigned char lds_raw[];
    LAS unsigned char* lds = (LAS unsigned char*)lds_raw;
    volatile LAS unsigned* MISC = (volatile LAS unsigned*)(lds + MISC_OFF);
    const int tid = threadIdx.x, lane = tid & 63, wave = __builtin_amdgcn_readfirstlane(tid >> 6);
    const int G = gridDim.x, cu = blockIdx.x;
    unsigned char* ws = args.ws; float* out = args.out;
    for (int u = tid; u < (LDS_BYTES - LDSCTL_OFF) / 4; u += NWAVES * 64) ((LAS unsigned*)(lds + LDSCTL_OFF))[u] = 0u;
    __syncthreads();
    XcdBarrier bar; bar.bar = (unsigned*)(ws + WS_CTL) + CW_BAR; bar.x = 0; bar.st = nullptr;
    if (MK_N_LAUNCHES == 1) bar = xcd_barrier_post((unsigned*)(ws + WS_CTL) + CW_BAR, MISC + 8);
    const int lo = args.ph_lo, hi = args.ph_hi;
#define IN(k) (lo <= (k) && (k) < hi)
#define SEAM(k) do { if (IN(k) && IN((k) + 1)) xcd_barrier(bar); } while (0)

    bf16_t* WIN = (bf16_t*)(ws + WS_WIN); bf16_t* WGO = (bf16_t*)(ws + WS_WGO); bf16_t* WPO = (bf16_t*)(ws + WS_WPO); bf16_t* WOUT = (bf16_t*)(ws + WS_WOUT);
    bf16_t* WGU = (bf16_t*)(ws + WS_WGU); bf16_t* WD = (bf16_t*)(ws + WS_WD); bf16_t* WPT = (bf16_t*)(ws + WS_WPT); bf16_t* WST = (bf16_t*)(ws + WS_WST);
    float* VSSQ = (float*)(ws + WS_VSSQ); float* XSSQ = (float*)(ws + WS_XSSQ);
    bf16_t* H = (bf16_t*)(ws + WS_H); bf16_t* MERGED = (bf16_t*)(ws + WS_MERGED); bf16_t* ABUF = (bf16_t*)(ws + WS_A); bf16_t* ZU = (bf16_t*)(ws + WS_ZU); bf16_t* X1B = (bf16_t*)(ws + WS_X1B);
    bf16_t* ZV = (bf16_t*)(ws + WS_ZV); bf16_t* GA = (bf16_t*)(ws + WS_GA); bf16_t* GB = (bf16_t*)(ws + WS_GB); bf16_t* ACT = (bf16_t*)(ws + WS_ACT);
    bf16_t* PA = (bf16_t*)(ws + WS_PA); bf16_t* SG = (bf16_t*)(ws + WS_SG);
    bf16_t* HS = (bf16_t*)(ws + WS_HS); float* PROJS = (float*)(ws + WS_PROJS); bf16_t* PAS = (bf16_t*)(ws + WS_PAS); bf16_t* SGS = (bf16_t*)(ws + WS_SGS);
    bf16_t* MERGEDS = (bf16_t*)(ws + WS_MERGEDS); bf16_t* X1SB = (bf16_t*)(ws + WS_X1SB); float* SSQS = (float*)(ws + WS_SSQS); bf16_t* ACTS = (bf16_t*)(ws + WS_ACTS);
    LAS float* red = (LAS float*)lds;

    if (IN(0)) {
        LAS float* scr = (LAS float*)(lds + wave * 16384);
        const int gw = cu * NWAVES + wave, NGW = G * NWAVES;
        constexpr int I_IN = 16 * 112, I_GO = 8 * 32, I_PO = 8 * 32, I_OUT = 16 * 32, I_G = 16 * 88, I_U = 16 * 88, I_D = 44 * 32, I_P = 4 * 8;
        constexpr int NITEMS = I_IN + I_GO + I_PO + I_OUT + I_G + I_U + I_D + I_P;
        for (int it = gw; it < NITEMS; it += NGW) {
            int r = it;
            if (r < I_IN) { const int kb = r / 112, nb = r % 112; tr_item(args.in[I_WIN], INW, WIN, D, scr, 64 * kb, 32 * nb, 32 * nb, lane, nullptr); continue; } r -= I_IN;
            if (r < I_GO) { const int kb = r / 32, nb = r % 32; tr_item(args.in[I_WGO], D, WGO, 512, scr, 64 * kb, 32 * nb, 32 * nb, lane, nullptr); continue; } r -= I_GO;
            if (r < I_PO) { const int kb = r / 32, nb = r % 32; tr_item(args.in[I_WPO], D, WPO, 512, scr, 64 * kb, 32 * nb, 32 * nb, lane, nullptr); continue; } r -= I_PO;
            if (r < I_OUT) { const int kb = r / 32, nb = r % 32; tr_item(args.in[I_WOUT], D, WOUT, D, scr, 64 * kb, 32 * nb, 32 * nb, lane, nullptr); continue; } r -= I_OUT;
            if (r < I_G) { const int kb = r / 88, nb = r % 88, n0 = 32 * nb; tr_item(args.in[I_WG], DFF, WGU, D, scr, 64 * kb, n0, (n0 >> 7) * 256 + (n0 & 127), lane, args.in[I_GFFN]); continue; } r -= I_G;
            if (r < I_U) { const int kb = r / 88, nb = r % 88, n0 = 32 * nb; tr_item(args.in[I_WU], DFF, WGU, D, scr, 64 * kb, n0, (n0 >> 7) * 256 + 128 + (n0 & 127), lane, args.in[I_GFFN]); continue; } r -= I_U;
            if (r < I_D) { const int kb = r / 32, nb = r % 32; tr_item(args.in[I_WD], D, WD, DFF, scr, 64 * kb, 32 * nb, 32 * nb, lane, nullptr); continue; } r -= I_D;
            { const int g = r >> 3, kb = (r >> 2) & 1, nb = r & 3; tr_item(args.in[I_WPOOL] + (size_t)g * 16384, 128, WPT + (size_t)g * 16384, 128, scr, 64 * kb, 32 * nb, 32 * nb, lane, nullptr); }
        }
        for (int it = gw; it < 1024; it += NGW) { const int e = it * 64 + lane, i = (e >> 7) & 127, j = e & 127; WST[e] = (j <= i) ? f2bf(args.in[I_WS][e]) : (bf16_t)0; }
        for (int m = gw; m < M + NS; m += NGW) {
            if (m < M) norm_row_bf16(args.in[I_XP] + (size_t)m * D, args.in[I_GMIX], H + (size_t)m * D, lane);
            else norm_row_bf16(args.in[I_XS] + (size_t)(m - M) * D, args.in[I_GMIX], HS + (size_t)(m - M) * D, lane);
        }
        __syncthreads();
    }
    SEAM(0);

    if (IN(1)) {
        pg8::Gemm g{H, H, WIN, WIN, D}; pg8::StaticOrder S; S.init(M, INW, G, cu, 1);
        pg8::EpiProj E{ABUF, ZU, ZV, GA, GB, VSSQ, out + O_PP};
        pg8::gemm_phase<pg8::EpiProj, true>(lds, g, S, E);
        const int half = G / 2;
        if (cu >= half) for (int t = cu - half; t < 4 * 224; t += G - half) {
            const int rt = t & 3, ct = t >> 2; f32x4 a0 = (f32x4){0.f, 0.f, 0.f, 0.f}, a1 = a0;
            mini_acc<4>(a0, a1, HS + (size_t)rt * 32 * D, D, WIN + (size_t)ct * 16 * D, D, wave, lane);
            float v = mini_reduce(red, a0, a1, tid, wave, lane);
            const int row = rt * 32 + (tid >> 4), col = ct * 16 + (tid & 15);
            if (col < 512) out[O_PS + ((size_t)row * PST + 14) * PW + col] = v;
            else if (col < 1536) v = gelu_f(v);
            else v = sigmoid_f(v);
            PROJS[(size_t)row * INW + col] = v;
        }
    }
    SEAM(1);

    if (IN(2)) {
        for (int u = cu; u < 1024; u += G) {
            const int ch = (u >> 1) & 127, type = u & 1, grp = u >> 8;
            if (type == 0) p2_pool_unit(lds, ch, grp, ABUF, WPT, args.in[I_SPOOL], PA, tid, wave, lane);
            else p2_gate_unit(lds, ch, grp, ZU, ZV, VSSQ, WST, args.in[I_GV], args.in[I_BS], SG, tid, wave, lane);
        }
        if (cu < 8) {
            LAS bf16_t* pbuf = (LAS bf16_t*)lds;
            const float* state = args.in[I_STATE];
            for (int q = 0; q < 2; ++q) {
                const int rr = 2 * wave + q, b = cu * 16 + rr; float zvv[8]; float ss = 0.f;
#pragma unroll
                for (int j = 0; j < 8; ++j) { zvv[j] = PROJS[(size_t)b * INW + 1024 + lane + 64 * j]; ss += zvv[j] * zvv[j]; }
                const float r = rsqrtf(wave_sum(ss) * (1.f / GWID) + EPS);
#pragma unroll
                for (int j = 0; j < 8; ++j) {
                    const int col = lane + 64 * j, gi = col >> 7, wnd = 2 << gi;
                    const float v = zvv[j] * r * args.in[I_GV][col];
                    out[O_VS + (size_t)b * GWID + col] = v;
                    const float s = args.in[I_WS][(size_t)gi * 16384] * v + args.in[I_BS][gi * 128];
                    SGS[(size_t)b * GWID + col] = f2bf(PROJS[(size_t)b * INW + 512 + col] * s);
                    const float an = PROJS[(size_t)b * INW + col]; float sum = an;
                    for (int s2 = 16 - wnd; s2 < 15; ++s2) sum += state[((size_t)b * PST + s2) * PW + col];
                    pbuf[rr * 520 + col] = f2bf(sum / (float)wnd - an);
                    for (int s2 = 1; s2 < 15; ++s2) out[O_PS + ((size_t)b * PST + s2 - 1) * PW + col] = state[((size_t)b * PST + s2) * PW + col];
                }
            }
            __syncthreads();
            const int fr = lane & 15, fq = lane >> 4;
#pragma unroll
            for (int q = 0; q < 4; ++q) {
                const int d0 = 16 * (4 * wave + q), g = d0 >> 7, dl = d0 & 127; f32x4 acc = (f32x4){0.f, 0.f, 0.f, 0.f};
#pragma unroll
                for (int ks = 0; ks < 4; ++ks) {
                    const bf16x8 wf = *(const bf16x8*)(WPT + (size_t)g * 16384 + (dl + fr) * 128 + 32 * ks + 8 * fq);
                    const bf16x8 pf = *(const LAS bf16x8*)(pbuf + fr * 520 + g * 128 + 32 * ks + 8 * fq);
                    acc = __builtin_amdgcn_mfma_f32_16x16x32_bf16(wf, pf, acc, 0, 0, 0);
                }
                const f32x4 sp = *(const f32x4*)(args.in[I_SPOOL] + d0 + 4 * fq); acc = acc * sp;
                u32x2 w; w.x = cvt_pk_bf16(acc[0], acc[1]); w.y = cvt_pk_bf16(acc[2], acc[3]);
                *(u32x2*)(PAS + (size_t)(cu * 16 + fr) * PW + d0 + 4 * fq) = w;
            }
            __syncthreads();
        }
    }
    SEAM(2);

    if (IN(3)) {
        pg8::Gemm g{SG, PA, WGO, WPO, 512}; pg8::StaticOrder S; S.init(M, D, G, cu, 2);
        pg8::EpiMerge E{GA, GB, MERGED};
        pg8::gemm_phase<pg8::EpiMerge, true>(lds, g, S, E);
        for (int t = cu; t < 256; t += G) {
            const int rt = t & 3, ct = t >> 2; f32x4 p0 = (f32x4){0.f, 0.f, 0.f, 0.f}, p1 = p0, q0 = p0, q1 = p0;
            mini_acc<2>(p0, p1, PAS + (size_t)rt * 32 * PW, PW, WPO + (size_t)ct * 16 * 512, 512, wave, lane);
            mini_acc<2>(q0, q1, SGS + (size_t)rt * 32 * GWID, GWID, WGO + (size_t)ct * 16 * 512, 512, wave, lane);
            const float vp = mini_reduce(red, p0, p1, tid, wave, lane), vg = mini_reduce(red + 4096, q0, q1, tid, wave, lane);
            const int row = rt * 32 + (tid >> 4), col = ct * 16 + (tid & 15);
            MERGEDS[(size_t)row * D + col] = f2bf(PROJS[(size_t)row * INW + 1536 + col] * vp + PROJS[(size_t)row * INW + 2560 + col] * vg);
        }
    }
    SEAM(3);

    if (IN(4)) {
        pg8::Gemm g{MERGED, MERGED, WOUT, WOUT, D}; pg8::StaticOrder S; S.init(M, D, G, cu, 1);
        pg8::EpiWout E{args.in[I_XP], out + O_YP, X1B, XSSQ};
        pg8::gemm_phase<pg8::EpiWout, false>(lds, g, S, E);
        for (int t = cu; t < 256; t += G) {
            const int rt = t & 3, ct = t >> 2; f32x4 a0 = (f32x4){0.f, 0.f, 0.f, 0.f}, a1 = a0;
            mini_acc<4>(a0, a1, MERGEDS + (size_t)rt * 32 * D, D, WOUT + (size_t)ct * 16 * D, D, wave, lane);
            const int row = rt * 32 + (tid >> 4), col = ct * 16 + (tid & 15);
            const float v = mini_reduce(red, a0, a1, tid, wave, lane) + args.in[I_XS][(size_t)row * D + col];
            out[O_YS + (size_t)row * D + col] = v; X1SB[(size_t)row * D + col] = f2bf(v);
            float ss = v * v; ss += __shfl_xor(ss, 1); ss += __shfl_xor(ss, 2); ss += __shfl_xor(ss, 4); ss += __shfl_xor(ss, 8);
            if ((tid & 15) == 0) SSQS[(size_t)row * 64 + ct] = ss;
        }
    }
    SEAM(4);

    if (IN(5)) {
        pg8::Gemm g{X1B, X1B, WGU, WGU, D}; pg8::StaticOrder S; S.init(M, 2 * DFF, G, cu, 1);
        pg8::EpiGU E{XSSQ, ACT};
        pg8::gemm_phase<pg8::EpiGU, true>(lds, g, S, E);
        const int half = G / 2;
        if (cu >= half) for (int t = cu - half; t < 4 * 176; t += G - half) {
            const int rt = t & 3, ct = t >> 2, p = ct >> 3, j0 = (ct & 7) * 16; f32x4 g0 = (f32x4){0.f, 0.f, 0.f, 0.f}, g1 = g0, u0 = g0, u1 = g0;
            mini_acc<4>(g0, g1, X1SB + (size_t)rt * 32 * D, D, WGU + (size_t)(256 * p + j0) * D, D, wave, lane);
            mini_acc<4>(u0, u1, X1SB + (size_t)rt * 32 * D, D, WGU + (size_t)(256 * p + 128 + j0) * D, D, wave, lane);
            const float vg = mini_reduce(red, g0, g1, tid, wave, lane), vu = mini_reduce(red + 4096, u0, u1, tid, wave, lane);
            const int row = rt * 32 + (tid >> 4), col = tid & 15;
            const f32x4 s4 = *(const f32x4*)(SSQS + (size_t)row * 64 + 4 * col); float ss = (s4[0] + s4[1]) + (s4[2] + s4[3]);
            ss += __shfl_xor(ss, 1); ss += __shfl_xor(ss, 2); ss += __shfl_xor(ss, 4); ss += __shfl_xor(ss, 8);
            const float r = rsqrtf(ss * (1.f / D) + EPS), gg = vg * r;
            ACTS[(size_t)row * DFF + ct * 16 + col] = f2bf(gg * sigmoid_f(gg) * (vu * r));
        }
    }
    SEAM(5);

    if (IN(6)) {
        pg8::Gemm g{ACT, ACT, WD, WD, DFF}; pg8::StaticOrder S; S.init(M, D, G, cu, 1);
        pg8::EpiDown E{out + O_YP};
        pg8::gemm_phase<pg8::EpiDown, false>(lds, g, S, E);
        for (int t = cu; t < 256; t += G) {
            const int rt = t & 3, ct = t >> 2; f32x4 a0 = (f32x4){0.f, 0.f, 0.f, 0.f}, a1 = a0;
            mini_acc<11>(a0, a1, ACTS + (size_t)rt * 32 * DFF, DFF, WD + (size_t)ct * 16 * DFF, DFF, wave, lane);
            const int row = rt * 32 + (tid >> 4), col = ct * 16 + (tid & 15);
            out[O_YS + (size_t)row * D + col] += mini_reduce(red, a0, a1, tid, wave, lane);
        }
    }
    SEAM(6);

    if (IN(7)) {
        const int gw = cu * NWAVES + wave, NGW = G * NWAVES; const f32x4* gr = (const f32x4*)args.in[I_GFINAL] + lane;
        for (int m = gw; m < M + NS; m += NGW) {
            f32x4* xr = (f32x4*)(out + (size_t)m * D) + lane; f32x4 v[4]; float s = 0.f;
#pragma unroll
            for (int j = 0; j < 4; ++j) { v[j] = xr[64 * j]; s += (v[j][0] * v[j][0] + v[j][1] * v[j][1]) + (v[j][2] * v[j][2] + v[j][3] * v[j][3]); }
            const float r = rsqrtf(wave_sum(s) * (1.f / D) + EPS);
#pragma unroll
            for (int j = 0; j < 4; ++j) xr[64 * j] = v[j] * r * gr[64 * j];
        }
    }
#undef IN
#undef SEAM
}

extern "C" void kernel_launch(void* const* d_in, const int* in_sizes, int n_in, void* d_out, int out_size, void* d_ws, size_t ws_size, hipStream_t stream) {
    static int grid = 0;
    if (grid == 0) {
        if (n_in != 18 || ws_size < WS_END) { fprintf(stderr, "kernel_launch: built for 18 inputs and >= %zu bytes of workspace; got n_in %d, ws %zu\n", (size_t)WS_END, n_in, ws_size); grid = -1; return; }
        int dev = 0, cus = 0, per_cu = 0;
        if (hipGetDevice(&dev) != hipSuccess || hipDeviceGetAttribute(&cus, hipDeviceAttributeMultiprocessorCount, dev) != hipSuccess) { fprintf(stderr, "kernel_launch: device query failed\n"); grid = -1; return; }
        if (hipFuncSetAttribute((const void*)fwd_kernel, hipFuncAttributeMaxDynamicSharedMemorySize, LDS_BYTES) != hipSuccess) { fprintf(stderr, "kernel_launch: hipFuncSetAttribute failed\n"); grid = -1; return; }
        if (hipOccupancyMaxActiveBlocksPerMultiprocessor(&per_cu, (const void*)fwd_kernel, NWAVES * 64, LDS_BYTES) != hipSuccess || per_cu < 1)
            fprintf(stderr, "kernel_launch: occupancy query reports %d workgroups per CU\n", per_cu);
        (void)hipGetLastError();
        grid = cus;
    }
    if (grid < 0) return;
    (void)hipMemsetAsync((char*)d_ws + WS_CTL, 0, CTL_ZERO_BYTES, stream);
    Args a{};
    for (int i = 0; i < 18; ++i) a.in[i] = (const float*)d_in[i];
    a.out = (float*)d_out; a.ws = (unsigned char*)d_ws;
    if (MK_N_LAUNCHES == 1) { a.ph_lo = 0; a.ph_hi = 8; hipLaunchKernelGGL(fwd_kernel, dim3(grid), dim3(NWAVES * 64), LDS_BYTES, stream, a); }
    else for (int li = 0; li < 8; ++li) { a.ph_lo = li; a.ph_hi = li + 1; hipLaunchKernelGGL(fwd_kernel, dim3(grid), dim3(NWAVES * 64), LDS_BYTES, stream, a); }
    const hipError_t le = hipPeekAtLastError();
    if (le != hipSuccess) fprintf(stderr, "kernel_launch: launch failed: %s\n", hipGetErrorName(le));
}
```

```cpp
#include <hip/hip_runtime.h>
#include <cstdio>
#include <cstdint>

#ifndef MK_N_LAUNCHES
#define MK_N_LAUNCHES 1
#endif

#ifndef PROBE_REPEAT_PHASE
#define PROBE_REPEAT_PHASE -1
#endif
#define LAS __attribute__((address_space(3)))
#define GAS __attribute__((address_space(1)))
typedef unsigned short bf16_t;
typedef short bf16x8 __attribute__((ext_vector_type(8)));
typedef float f32x4 __attribute__((ext_vector_type(4)));
typedef float f32x2 __attribute__((ext_vector_type(2)));
typedef unsigned u32x4 __attribute__((ext_vector_type(4)));
typedef unsigned u32x2 __attribute__((ext_vector_type(2)));

constexpr int D = 1024, SEQ = 2048, NB = 8, M = NB * SEQ, NS = 128, PW = 512, GWID = 512, DFF = 2816, INW = 3584, PST = 15;
constexpr float EPS = 1e-6f;
constexpr size_t O_YP = 0, O_YS = (size_t)M * D, O_PP = O_YS + (size_t)NS * D, O_PS = O_PP + (size_t)NB * PST * PW, O_VS = O_PS + (size_t)NS * PST * PW;

constexpr size_t MiB = 1u << 20, KiB = 1u << 10;
constexpr size_t WS_CTL = 0, CTL_ZERO_BYTES = 64 * KiB;
constexpr size_t WS_WIN = 1 * MiB, WS_WGO = 8 * MiB, WS_WPO = 9 * MiB, WS_WOUT = 10 * MiB, WS_WGU = 12 * MiB, WS_WD = 23 * MiB;
constexpr size_t WS_WPT = 29 * MiB, WS_WST = 29 * MiB + 128 * KiB;
constexpr size_t WS_VSSQ = 30 * MiB, WS_XSSQ = 30 * MiB + 512 * KiB;
constexpr size_t WS_H = 32 * MiB, WS_MERGED = 32 * MiB;
constexpr size_t WS_A = 64 * MiB, WS_ZU = 80 * MiB, WS_X1B = 64 * MiB;
constexpr size_t WS_ZV = 96 * MiB, WS_GA = 112 * MiB, WS_GB = 144 * MiB, WS_ACT = 96 * MiB;
constexpr size_t WS_PA = 184 * MiB, WS_SG = 200 * MiB;
constexpr size_t WS_S = 216 * MiB;
constexpr size_t WS_HS = WS_S, WS_PROJS = WS_S + 256 * KiB, WS_PS = WS_S + 2048 * KiB, WS_PAS = WS_S + 2304 * KiB, WS_SGS = WS_S + 2432 * KiB,
                 WS_MERGEDS = WS_S + 2560 * KiB, WS_X1SB = WS_S + 2816 * KiB, WS_SSQS = WS_S + 3072 * KiB, WS_ACTS = WS_S + 3200 * KiB;
constexpr size_t WS_END = 224 * MiB;
constexpr int CW_BAR = 1024;

constexpr int NWAVES = 8;
constexpr int RING_BYTES = 131072, LDSCTL_OFF = RING_BYTES, MISC_OFF = LDSCTL_OFF + 320, LDS_BYTES = 147456;

__device__ __forceinline__ unsigned cvt_pk_bf16(float lo, float hi) { unsigned r; asm volatile("v_cvt_pk_bf16_f32 %0, %1, %2" : "=v"(r) : "v"(lo), "v"(hi)); return r; }
__device__ __forceinline__ float bf_lo(unsigned w) { return __uint_as_float(w << 16); }
__device__ __forceinline__ float bf_hi(unsigned w) { return __uint_as_float(w & 0xffff0000u); }
__device__ __forceinline__ float bf2f(bf16_t b) { return __uint_as_float(((unsigned)b) << 16); }
__device__ __forceinline__ bf16_t f2bf(float f) { return (bf16_t)(cvt_pk_bf16(f, 0.f) & 0xffffu); }
__device__ __forceinline__ float sigmoid_f(float x) { return __builtin_amdgcn_rcpf(1.f + __builtin_amdgcn_exp2f(-1.4426950408889634f * x)); }
__device__ __forceinline__ float gelu_f(float x) { const float u = x * (1.f + 0.044715f * x * x); return x * __builtin_amdgcn_rcpf(1.f + __builtin_amdgcn_exp2f(-2.3022081986f * u)); }
__device__ __forceinline__ float wave_sum(float v) {
#pragma unroll
    for (int o = 1; o < 64; o <<= 1) v += __shfl_xor(v, o);
    return v;
}

namespace pg8 {
constexpr int BM = 256, BK = 64, HALF = 128, HTB = HALF * BK * 2, STAGE_BYTES = 8 * HTB, NXCD = 8, WGM = 8;
__host__ __device__ __forceinline__ int lds_byte(int r, int c) { const int st = (r >> 4) * 2 + (c >> 5), rr = r & 15, cc = c & 31, ob = rr * 64 + cc * 2; return st * 1024 + (ob ^ (((ob >> 9) & 1) << 5)); }
__host__ __device__ __forceinline__ void stage_rc(int b, int& R, int& C) { const int st = b / 1024, sb = b % 1024, swz = sb ^ (((sb >> 9) & 1) << 5); R = (st >> 1) * 16 + swz / 64; C = (st & 1) * 32 + (swz % 64) / 2; }
__host__ __device__ __forceinline__ int perm32(int rho) { const int n = rho >> 4, i = rho & 15; return 8 * (i >> 2) + 4 * n + (i & 3); }

struct Unit { int pm, pn, part; };
struct Gemm { const bf16_t* A0; const bf16_t* A1; const bf16_t* B0; const bf16_t* B1; int K; };

struct StaticOrder {
    int nM, nN, nwg, G, c, NP;
    __host__ __device__ void init(int M_, int N_, int G_, int c_, int NP_) { nM = M_ / BM; nN = N_ / BM; nwg = nM * nN; G = G_; c = c_; NP = NP_; }
    __host__ __device__ bool next(int i, Unit& u) const {
        const int ii = i / NP; u.part = i - ii * NP;
        const long L = (long)ii * G + c; if (L >= nwg) return false;
        int wgid = (int)L; { const int q = nwg / NXCD, r = nwg % NXCD, xcd = wgid % NXCD, off = wgid / NXCD; wgid = (xcd < r ? xcd * (q + 1) : r * (q + 1) + (xcd - r) * q) + off; }
        const int nig = WGM * nN, gid = wgid / nig, fm = gid * WGM, gsz = (nM - fm) < WGM ? (nM - fm) : WGM;
        u.pm = fm + ((wgid % nig) % gsz); u.pn = (wgid % nig) / gsz; return true;
    }
};

typedef f32x4 Acc[2][2][4][2];

struct EpiProj {
    static constexpr bool PERM = true;
    bf16_t *a, *zu, *zv, *ga, *gb; float* vssq; float* pool_out;
    __device__ __forceinline__ bool keep(const Unit&) const { return false; }
    __device__ __forceinline__ void operator()(Acc& acc, const Unit& u, int wr, int wc, int fr, int fq) const {
        const int pn = u.pn; int kind, ldc, colt; bf16_t* base;
        if (pn < 2) { kind = 0; base = a; ldc = 512; colt = pn * 256; }
        else if (pn < 4) { kind = 1; base = zu; ldc = 512; colt = (pn - 2) * 256; }
        else if (pn < 6) { kind = 2; base = zv; ldc = 512; colt = (pn - 4) * 256; }
        else if (pn < 10) { kind = 3; base = ga; ldc = 1024; colt = (pn - 6) * 256; }
        else { kind = 3; base = gb; ldc = 1024; colt = (pn - 10) * 256; }
        const int row0 = u.pm * BM + wr * 64 + fr, col0 = colt + wc * 32 + 8 * fq;
        const bool poolpanel = (kind == 0) && ((u.pm & 7) == 7);
#pragma unroll
        for (int ai = 0; ai < 2; ++ai)
#pragma unroll
            for (int m = 0; m < 4; ++m) {
                const int row = row0 + ai * HALF + m * 16; bf16_t* rowp = base + (size_t)row * ldc + col0; float ss = 0.f;
#pragma unroll
                for (int bj = 0; bj < 2; ++bj) {
                    f32x4 v0 = acc[ai][bj][m][0], v1 = acc[ai][bj][m][1];
                    if (kind == 1 || kind == 2) {
#pragma unroll
                        for (int i = 0; i < 4; ++i) { v0[i] = gelu_f(v0[i]); v1[i] = gelu_f(v1[i]); }
                        if (kind == 2) ss += (v0[0] * v0[0] + v0[1] * v0[1]) + (v0[2] * v0[2] + v0[3] * v0[3]) + (v1[0] * v1[0] + v1[1] * v1[1]) + (v1[2] * v1[2] + v1[3] * v1[3]);
                    } else if (kind == 3) {
#pragma unroll
                        for (int i = 0; i < 4; ++i) { v0[i] = sigmoid_f(v0[i]); v1[i] = sigmoid_f(v1[i]); }
                    }
                    u32x4 w; w.x = cvt_pk_bf16(v0[0], v0[1]); w.y = cvt_pk_bf16(v0[2], v0[3]); w.z = cvt_pk_bf16(v1[0], v1[1]); w.w = cvt_pk_bf16(v1[2], v1[3]);
                    *(u32x4*)(rowp + bj * HALF) = w;
                    if (poolpanel && ai == 1) {
                        const int tl = 1792 + 128 + wr * 64 + m * 16 + fr;
                        if (tl >= SEQ - PST) { float* pp = pool_out + ((size_t)((u.pm >> 3) * PST + tl - (SEQ - PST))) * PW + col0 + bj * HALF; *(f32x4*)pp = v0; *(f32x4*)(pp + 4) = v1; }
                    }
                }
                if (kind == 2) { ss += __shfl_xor(ss, 16); ss += __shfl_xor(ss, 32); if (fq == 0) vssq[(size_t)row * 8 + (pn - 4) * 4 + wc] = ss; }
            }
    }
};
struct EpiMerge {
    static constexpr bool PERM = true;
    const bf16_t *ga, *gb; bf16_t* out;
    __device__ __forceinline__ bool keep(const Unit& u) const { return u.part == 0; }
    __device__ __forceinline__ void operator()(Acc& acc, const Unit& u, int wr, int wc, int fr, int fq) const {
        const int row0 = u.pm * BM + wr * 64 + fr, col0 = u.pn * BM + wc * 32 + 8 * fq;
#pragma unroll
        for (int ai = 0; ai < 2; ++ai)
#pragma unroll
            for (int m = 0; m < 4; ++m) {
#pragma unroll
                for (int bj = 0; bj < 2; ++bj) {
                    const size_t off = (size_t)(row0 + ai * HALF + m * 16) * D + col0 + bj * HALF;
                    const u32x4 g1 = *(const u32x4*)(ga + off);
                    float a8[8] = {bf_lo(g1.x), bf_hi(g1.x), bf_lo(g1.y), bf_hi(g1.y), bf_lo(g1.z), bf_hi(g1.z), bf_lo(g1.w), bf_hi(g1.w)};
                    if (u.part == 0) {
                        const u32x4 g2 = *(const u32x4*)(gb + off);
                        const float b8[8] = {bf_lo(g2.x), bf_hi(g2.x), bf_lo(g2.y), bf_hi(g2.y), bf_lo(g2.z), bf_hi(g2.z), bf_lo(g2.w), bf_hi(g2.w)};
#pragma unroll
                        for (int i = 0; i < 4; ++i) { acc[ai][bj][m][0][i] *= b8[i] * __builtin_amdgcn_rcpf(fmaxf(a8[i], 1e-30f)); acc[ai][bj][m][1][i] *= b8[4 + i] * __builtin_amdgcn_rcpf(fmaxf(a8[4 + i], 1e-30f)); }
                    } else {
                        const f32x4 v0 = acc[ai][bj][m][0], v1 = acc[ai][bj][m][1];
                        u32x4 w; w.x = cvt_pk_bf16(v0[0] * a8[0], v0[1] * a8[1]); w.y = cvt_pk_bf16(v0[2] * a8[2], v0[3] * a8[3]); w.z = cvt_pk_bf16(v1[0] * a8[4], v1[1] * a8[5]); w.w = cvt_pk_bf16(v1[2] * a8[6], v1[3] * a8[7]);
                        *(u32x4*)(out + off) = w;
                    }
                }
                if (m & 1) asm volatile("" ::: "memory");
            }
    }
};
struct EpiWout {
    static constexpr bool PERM = false;
    const float* x; float* x1; bf16_t* x1b; float* xssq;
    __device__ __forceinline__ bool keep(const Unit&) const { return false; }
    __device__ __forceinline__ void operator()(Acc& acc, const Unit& u, int wr, int wc, int fr, int fq) const {
        const int col0 = u.pn * BM + wc * 32 + 4 * fq;
#pragma unroll
        for (int ai = 0; ai < 2; ++ai)
#pragma unroll
            for (int m = 0; m < 4; ++m) {
                const int r = u.pm * BM + ai * HALF + wr * 64 + m * 16 + fr; const size_t off = (size_t)r * D + col0; float ss = 0.f;
#pragma unroll
                for (int bj = 0; bj < 2; ++bj)
#pragma unroll
                    for (int n = 0; n < 2; ++n) {
                        const f32x4 o = *(const f32x4*)(x + off + bj * HALF + n * 16) + acc[ai][bj][m][n];
                        *(f32x4*)(x1 + off + bj * HALF + n * 16) = o;
                        u32x2 w; w.x = cvt_pk_bf16(o[0], o[1]); w.y = cvt_pk_bf16(o[2], o[3]); *(u32x2*)(x1b + off + bj * HALF + n * 16) = w;
                        ss += (o[0] * o[0] + o[1] * o[1]) + (o[2] * o[2] + o[3] * o[3]);
                    }
                ss += __shfl_xor(ss, 16); ss += __shfl_xor(ss, 32);
                if (fq == 0) xssq[(size_t)r * 16 + u.pn * 4 + wc] = ss;
                if (m & 1) asm volatile("" ::: "memory");
            }
    }
};
struct EpiGU {
    static constexpr bool PERM = true;
    const float* xssq; bf16_t* act;
    __device__ __forceinline__ bool keep(const Unit&) const { return false; }
    __device__ __forceinline__ void operator()(Acc& acc, const Unit& u, int wr, int wc, int fr, int fq) const {
        const int row0 = u.pm * BM + wr * 64 + fr, col0 = u.pn * HALF + wc * 32 + 8 * fq;
#pragma unroll
        for (int ai = 0; ai < 2; ++ai)
#pragma unroll
            for (int m = 0; m < 4; ++m) {
                const int row = row0 + ai * HALF + m * 16; const f32x4* sp = (const f32x4*)(xssq + (size_t)row * 16);
                const f32x4 s4 = (sp[0] + sp[1]) + (sp[2] + sp[3]); const float r = rsqrtf(((s4[0] + s4[1]) + (s4[2] + s4[3])) * (1.f / D) + EPS);
                float o[8];
#pragma unroll
                for (int n = 0; n < 2; ++n)
#pragma unroll
                    for (int i = 0; i < 4; ++i) { const float g = acc[ai][0][m][n][i] * r, uu = acc[ai][1][m][n][i] * r; o[n * 4 + i] = g * sigmoid_f(g) * uu; }
                u32x4 w; w.x = cvt_pk_bf16(o[0], o[1]); w.y = cvt_pk_bf16(o[2], o[3]); w.z = cvt_pk_bf16(o[4], o[5]); w.w = cvt_pk_bf16(o[6], o[7]);
                *(u32x4*)(act + (size_t)row * DFF + col0) = w;
                if (m & 1) asm volatile("" ::: "memory");
            }
    }
};
struct EpiDown {
    static constexpr bool PERM = false;
    float* x1;
    __device__ __forceinline__ bool keep(const Unit&) const { return false; }
    __device__ __forceinline__ void operator()(Acc& acc, const Unit& u, int wr, int wc, int fr, int fq) const {
        const int col0 = u.pn * BM + wc * 32 + 4 * fq;
#pragma unroll
        for (int ai = 0; ai < 2; ++ai)
#pragma unroll
            for (int m = 0; m < 4; ++m) {
                const int r = u.pm * BM + ai * HALF + wr * 64 + m * 16 + fr; const size_t off = (size_t)r * D + col0;
#pragma unroll
                for (int bj = 0; bj < 2; ++bj)
#pragma unroll
                    for (int n = 0; n < 2; ++n) { float* p = x1 + off + bj * HALF + n * 16; *(f32x4*)p = *(const f32x4*)p + acc[ai][bj][m][n]; }
                if (m & 1) asm volatile("" ::: "memory");
            }
    }
};

template <class Epi, bool ALIGN_EPI>
__device__ __forceinline__ void gemm_phase(LAS unsigned char* lds, const Gemm g, const StaticOrder& S, const Epi& E) {
    const int tid = threadIdx.x, wid = __builtin_amdgcn_readfirstlane(tid >> 6), lane = tid & 63, wr = wid >> 2, wc = wid & 3, fr = lane & 15, fq = lane >> 4;
    const int K = g.K, nt = K / BK;
    unsigned voffA[2], voffB[2];
#pragma unroll
    for (int i = 0; i < 2; ++i) { int R, C; stage_rc(tid * 16 + i * 8192, R, C); const int Rb = Epi::PERM ? ((R & ~31) + perm32(R & 31)) : R;
        voffA[i] = (unsigned)(R * K + C) * 2u; voffB[i] = (unsigned)(Rb * K + C) * 2u; }
    const size_t kstep = (size_t)(BK * 2);
    const size_t hstep = (size_t)HALF * K * 2;
    const size_t tstep = 2 * hstep;
    const unsigned ldsw = (unsigned)wid * 1024u;
    const int aoff = lds_byte(wr * 64 + fr, fq * 8), boff = lds_byte(wc * 32 + fr, fq * 8);
#define PG8_SA(b, h) (((b) * 2 + (h)) * HTB)
#define PG8_SB(b, h) ((4 + (b) * 2 + (h)) * HTB)
#define PG8_STAGE(bufoff, gbase, voff) do { _Pragma("unroll") for (int _i = 0; _i < 2; ++_i) \
        __builtin_amdgcn_global_load_lds((const unsigned*)((const char*)(gbase) + (voff)[_i]), (LAS unsigned*)(lds + (bufoff) + ldsw + _i * 8192), 16, 0, 0); } while (0)
#define PG8_LDA(dst, b, h) do { _Pragma("unroll") for (int m = 0; m < 4; ++m) _Pragma("unroll") for (int k = 0; k < 2; ++k) dst[m][k] = *(const LAS bf16x8*)(lds + PG8_SA(b, h) + aoff + m * 2048 + k * 1024); } while (0)
#define PG8_LDB(dst, b, h) do { _Pragma("unroll") for (int n = 0; n < 2; ++n) _Pragma("unroll") for (int k = 0; k < 2; ++k) dst[n][k] = *(const LAS bf16x8*)(lds + PG8_SB(b, h) + boff + n * 2048 + k * 1024); } while (0)
#define PG8_MMA(ai, bj, At, Bt) do { __builtin_amdgcn_s_setprio(1); _Pragma("unroll") for (int m = 0; m < 4; ++m) _Pragma("unroll") for (int n = 0; n < 2; ++n) _Pragma("unroll") for (int k = 0; k < 2; ++k) \
        acc[ai][bj][m][n] = __builtin_amdgcn_mfma_f32_16x16x32_bf16(Bt[n][k], At[m][k], acc[ai][bj][m][n], 0, 0, 0); __builtin_amdgcn_s_setprio(0); } while (0)
#define PG8_WAIT_V(n) asm volatile("s_waitcnt vmcnt(" #n ")" ::: "memory")
#define PG8_WAIT_L(n) asm volatile("s_waitcnt lgkmcnt(" #n ")" ::: "memory")
#define PG8_BAR __builtin_amdgcn_s_barrier()
#define PG8_SCHED __builtin_amdgcn_sched_barrier(0)
#define PG8_APTR(u) ((const char*)((u).part ? g.A1 : g.A0) + (size_t)(u).pm * tstep)
#define PG8_BPTR(u) ((const char*)((u).part ? g.B1 : g.B0) + (size_t)(u).pn * tstep)
    Unit cur, nxt; int ui = 0;
    if (!S.next(0, cur)) return;
    Acc acc;
#pragma unroll
    for (int a = 0; a < 2; ++a)
#pragma unroll
        for (int b = 0; b < 2; ++b)
#pragma unroll
            for (int m = 0; m < 4; ++m)
#pragma unroll
                for (int n = 0; n < 2; ++n) acc[a][b][m][n] = (f32x4){0.f, 0.f, 0.f, 0.f};
    bf16x8 At[4][2], B0[2][2], B1[2][2];
    const char* cA = PG8_APTR(cur); const char* cB = PG8_BPTR(cur);
    PG8_STAGE(PG8_SB(0, 0), cB, voffB); PG8_STAGE(PG8_SB(0, 1), cB + hstep, voffB); PG8_STAGE(PG8_SA(0, 0), cA, voffA); PG8_STAGE(PG8_SA(0, 1), cA + hstep, voffA);
    if (wr == 1) PG8_BAR;
    PG8_WAIT_V(2); PG8_BAR;
    PG8_STAGE(PG8_SB(1, 0), cB + kstep, voffB); PG8_STAGE(PG8_SA(1, 0), cA + kstep, voffA); PG8_STAGE(PG8_SB(1, 1), cB + hstep + kstep, voffB);
    PG8_WAIT_V(6); PG8_BAR;
    for (;;) {
        const bool has_next = S.next(ui + 1, nxt);
        const char* nA = has_next ? PG8_APTR(nxt) : cA; const char* nB = has_next ? PG8_BPTR(nxt) : cB;
        for (int t = 0; t < nt; t += 2) {
            const bool last = (t == nt - 2);
            const char* a1 = cA + (size_t)(t + 1) * kstep;
            const char* a2 = last ? nA : cA + (size_t)(t + 2) * kstep; const char* b2 = last ? nB : cB + (size_t)(t + 2) * kstep;
            const char* a3 = a2 + kstep; const char* b3 = b2 + kstep;
            PG8_LDB(B0, 0, 0); PG8_LDB(B1, 0, 1); PG8_SCHED; PG8_LDA(At, 0, 0); PG8_STAGE(PG8_SA(1, 1), a1 + hstep, voffA);
            PG8_WAIT_V(8); PG8_WAIT_L(0); PG8_BAR; PG8_MMA(0, 0, At, B0); PG8_MMA(0, 1, At, B1); PG8_BAR; PG8_SCHED;
            PG8_LDA(At, 0, 1); PG8_STAGE(PG8_SB(0, 0), b2, voffB); PG8_STAGE(PG8_SB(0, 1), b2 + hstep, voffB); PG8_STAGE(PG8_SA(0, 0), a2, voffA);
            PG8_WAIT_V(8); PG8_WAIT_L(0); PG8_BAR; PG8_MMA(1, 0, At, B0); PG8_MMA(1, 1, At, B1); PG8_BAR; PG8_SCHED;
            PG8_LDB(B0, 1, 0); PG8_LDB(B1, 1, 1); PG8_SCHED; PG8_LDA(At, 1, 0); PG8_STAGE(PG8_SA(0, 1), a2 + hstep, voffA);
            PG8_WAIT_V(8); PG8_WAIT_L(0); PG8_BAR; PG8_MMA(0, 0, At, B0); PG8_MMA(0, 1, At, B1); PG8_BAR; PG8_SCHED;
            PG8_LDA(At, 1, 1); PG8_STAGE(PG8_SB(1, 0), b3, voffB); PG8_STAGE(PG8_SB(1, 1), b3 + hstep, voffB); PG8_STAGE(PG8_SA(1, 0), a3, voffA);
            PG8_WAIT_V(8); PG8_WAIT_L(0); PG8_BAR; PG8_MMA(1, 0, At, B0); PG8_MMA(1, 1, At, B1); PG8_BAR; PG8_SCHED;
        }
        if constexpr (ALIGN_EPI) { if (wr == 0) PG8_BAR; }
        E(acc, cur, wr, wc, fr, fq);
        if (!has_next) break;
        if (!E.keep(cur)) {
#pragma unroll
            for (int a = 0; a < 2; ++a)
#pragma unroll
                for (int b = 0; b < 2; ++b)
#pragma unroll
                    for (int m = 0; m < 4; ++m)
#pragma unroll
                        for (int n = 0; n < 2; ++n) acc[a][b][m][n] = (f32x4){0.f, 0.f, 0.f, 0.f};
        }
        cur = nxt; cA = nA; cB = nB; ++ui;
        if constexpr (ALIGN_EPI) { if (wr == 1) PG8_BAR; }
    }
    PG8_WAIT_V(0);
    if constexpr (!ALIGN_EPI) { if (wr == 0) PG8_BAR; }
    PG8_BAR;
#undef PG8_SA
#undef PG8_SB
#undef PG8_STAGE
#undef PG8_LDA
#undef PG8_LDB
#undef PG8_MMA
#undef PG8_WAIT_V
#undef PG8_WAIT_L
#undef PG8_BAR
#undef PG8_SCHED
#undef PG8_APTR
#undef PG8_BPTR
}
}

#define XB_TMO      128
#define XB_XCNT(j)  (256  + 64 * (j))
#define XB_XSUB(j)  (1280 + 64 * (j))
#define XB_XGEN(j)  (2304 + 64 * (j))
#define XB_TOP      3328
#define XB_TOPGEN   3392
#define XCD_BAR_WORDS 3456
#define XB_SPIN_CAP (1u << 18)
__device__ __forceinline__ unsigned xb_ld(unsigned* p)              { return __hip_atomic_load(p, __ATOMIC_RELAXED, __HIP_MEMORY_SCOPE_AGENT); }
__device__ __forceinline__ unsigned xb_add(unsigned* p, unsigned v) { return __hip_atomic_fetch_add(p, v, __ATOMIC_RELAXED, __HIP_MEMORY_SCOPE_AGENT); }
__device__ __forceinline__ unsigned xb_xcc_id() { return (unsigned)__builtin_amdgcn_s_getreg((3 << 11) | 20) & 0xFu; }
#define XB_SPIN(cond, bar) do { unsigned _sp = 0; while (cond) { __builtin_amdgcn_s_sleep(1); \
    if ((++_sp & 255u) == 0u) { if (xb_ld(&(bar)[XB_TMO])) break; if (_sp > XB_SPIN_CAP) { atomicAdd(&(bar)[XB_TMO], 1u); break; } } } } while (0)
struct XcdBarrier { unsigned* bar; unsigned x; volatile LAS unsigned* st; };
__device__ __forceinline__ XcdBarrier xcd_barrier_post(unsigned* bar, volatile LAS unsigned* st) {
    XcdBarrier b; b.bar = bar; b.x = xb_xcc_id(); b.st = st;
    if (threadIdx.x == 0) (void)xb_add(&bar[XB_XCNT(b.x)], 1u);
    return b;
}
__device__ __forceinline__ void xcd_barrier_complete(unsigned* bar, unsigned x, unsigned& nloc, unsigned& nx) {
    const unsigned G = gridDim.x * gridDim.y * gridDim.z;
    unsigned sum, cnt, mine, sp = 0u;
    for (;;) {
        sum = 0u; cnt = 0u; mine = 0u;
#pragma unroll
        for (unsigned j = 0; j < 16; ++j) { const unsigned c = xb_ld(&bar[XB_XCNT(j)]); sum += c; cnt += (c > 0u) ? 1u : 0u; mine = (j == x) ? c : mine; }
        if (sum == G) break;
        __builtin_amdgcn_s_sleep(1);
        if ((++sp & 255u) == 0u) { if (xb_ld(&bar[XB_TMO])) break; if (sp > XB_SPIN_CAP) { atomicAdd(&bar[XB_TMO], 1u); break; } }
    }
    nloc = mine > 0u ? mine : 1u; nx = cnt > 0u ? cnt : 1u;
}
__device__ __forceinline__ void xcd_barrier(const XcdBarrier& b) {
    asm volatile("s_waitcnt vmcnt(0)" ::: "memory");
    __syncthreads();
    if (threadIdx.x == 0) {
        unsigned* bar = b.bar;
        __builtin_amdgcn_s_waitcnt(0);
        unsigned nloc = b.st[0], nx = b.st[1];
        if (nloc == 0u) { xcd_barrier_complete(bar, b.x, nloc, nx); b.st[0] = nloc; b.st[1] = nx; }
        const unsigned old = xb_add(&bar[XB_XSUB(b.x)], 1u);
        const unsigned gen = old / nloc;
        if (old + 1u == (gen + 1u) * nloc) {
            __builtin_amdgcn_fence(__ATOMIC_RELEASE, "agent");
            asm volatile("s_waitcnt vmcnt(0)" ::: "memory");
            const unsigned og = xb_add(&bar[XB_TOP], 1u);
            const unsigned tg = og / nx;
            if (og + 1u == (tg + 1u) * nx) xb_add(&bar[XB_TOPGEN], 1u);
            else XB_SPIN(xb_ld(&bar[XB_TOPGEN]) == tg, bar);
            __builtin_amdgcn_fence(__ATOMIC_ACQUIRE, "agent");
            xb_add(&bar[XB_XGEN(b.x)], 1u);
            asm volatile("s_waitcnt vmcnt(0)" ::: "memory");
        } else {
            XB_SPIN(xb_ld(&bar[XB_XGEN(b.x)]) == gen, bar);
            __builtin_amdgcn_fence(__ATOMIC_ACQUIRE, "agent");
            asm volatile("s_waitcnt vmcnt(0)" ::: "memory");
        }
    }
    __syncthreads();
}

struct Args { const float* in[18]; float* out; unsigned char* ws; int ph_lo, ph_hi, li, pad; };
enum { I_XP = 0, I_XS, I_STATE, I_WIN, I_GMIX, I_WPOOL, I_SPOOL, I_WS, I_BS, I_GV, I_WPO, I_WGO, I_WOUT, I_GFFN, I_WG, I_WU, I_WD, I_GFINAL };

__device__ __forceinline__ void tr_item(const float* W, int ldw, bf16_t* WT, int ldt, LAS float* scr, int k0, int n0, int drow0, int lane, const float* ks) {
#pragma unroll 8
    for (int i = 0; i < 32; ++i) { const int kk = 2 * i + (lane >> 5); float v = W[(size_t)(k0 + kk) * ldw + n0 + (lane & 31)]; if (ks) v *= ks[k0 + kk]; scr[kk * 33 + (lane & 31)] = v; }
    asm volatile("s_waitcnt lgkmcnt(0)" ::: "memory");
    const int c = lane & 7;
#pragma unroll
    for (int j = 0; j < 4; ++j) { const int n = (lane >> 3) + 8 * j; const LAS float* s = scr + (8 * c) * 33 + n;
        u32x4 o; o.x = cvt_pk_bf16(s[0 * 33], s[1 * 33]); o.y = cvt_pk_bf16(s[2 * 33], s[3 * 33]); o.z = cvt_pk_bf16(s[4 * 33], s[5 * 33]); o.w = cvt_pk_bf16(s[6 * 33], s[7 * 33]);
        *(u32x4*)(WT + (size_t)(drow0 + n) * ldt + k0 + 8 * c) = o; }
    asm volatile("s_waitcnt lgkmcnt(0)" ::: "memory");
}
__device__ __forceinline__ void norm_row_bf16(const float* xrow, const float* gain, bf16_t* orow, int lane) {
    const f32x4* xr = (const f32x4*)xrow + lane; const f32x4* gr = (const f32x4*)gain + lane;
    f32x4 v[4]; float s = 0.f;
#pragma unroll
    for (int j = 0; j < 4; ++j) { v[j] = xr[64 * j]; s += (v[j][0] * v[j][0] + v[j][1] * v[j][1]) + (v[j][2] * v[j][2] + v[j][3] * v[j][3]); }
    const float r = rsqrtf(wave_sum(s) * (1.f / D) + EPS);
    u32x2* o8 = (u32x2*)orow + lane;
#pragma unroll
    for (int j = 0; j < 4; ++j) { const f32x4 g = gr[64 * j]; u32x2 w; w.x = cvt_pk_bf16(v[j][0] * r * g[0], v[j][1] * r * g[1]); w.y = cvt_pk_bf16(v[j][2] * r * g[2], v[j][3] * r * g[3]); o8[64 * j] = w; }
}

template <int STEPS>
__device__ __forceinline__ void mini_acc(f32x4& acc0, f32x4& acc1, const bf16_t* A, int lda, const bf16_t* Bt, int ldb, int wave, int lane) {
    const int fr = lane & 15, fq = lane >> 4;
    const bf16_t* ap = A + (size_t)fr * lda + wave * (STEPS * 32) + 8 * fq;
    const bf16_t* bp = Bt + (size_t)fr * ldb + wave * (STEPS * 32) + 8 * fq;
    bf16x8 a0[STEPS], a1[STEPS], b[STEPS];
#pragma unroll
    for (int s = 0; s < STEPS; ++s) { a0[s] = *(const bf16x8*)(ap + 32 * s); a1[s] = *(const bf16x8*)(ap + (size_t)16 * lda + 32 * s); b[s] = *(const bf16x8*)(bp + 32 * s); }
#pragma unroll
    for (int s = 0; s < STEPS; ++s) { acc0 = __builtin_amdgcn_mfma_f32_16x16x32_bf16(b[s], a0[s], acc0, 0, 0, 0); acc1 = __builtin_amdgcn_mfma_f32_16x16x32_bf16(b[s], a1[s], acc1, 0, 0, 0); }
}
__device__ __forceinline__ float mini_reduce(LAS float* red, const f32x4& acc0, const f32x4& acc1, int tid, int wave, int lane) {
    *(LAS f32x4*)(red + (wave * 2 + 0) * 256 + lane * 4) = acc0; *(LAS f32x4*)(red + (wave * 2 + 1) * 256 + lane * 4) = acc1;
    __syncthreads();
    const int row = tid >> 4, col = tid & 15, h = row >> 4, lp = (col >> 2) * 16 + (row & 15), reg = col & 3;
    float s = 0.f;
#pragma unroll
    for (int w = 0; w < 8; ++w) s += red[(w * 2 + h) * 256 + lp * 4 + reg];
    __syncthreads();
    return s;
}

constexpr int PSTR = 136;
__device__ __forceinline__ void p2_pool_unit(LAS unsigned char* lds, int ch, int gi, const bf16_t* a, const bf16_t* WPT, const float* s_pool, bf16_t* pa, int tid, int wave, int lane) {
    LAS bf16_t* abuf = (LAS bf16_t*)lds;
    LAS bf16_t* pbuf = (LAS bf16_t*)(lds + 40960);
    const int m0 = ch * 128; const bool first = (ch & 15) == 0;
    for (int q = tid; q < 143 * 16; q += 512) { const int s = q >> 4, cq = q & 15;
        u32x4 v = (u32x4){0u, 0u, 0u, 0u}; if (!(first && s < 15)) v = *(const u32x4*)(a + (size_t)(m0 - 15 + s) * PW + gi * 128 + cq * 8);
        *(LAS u32x4*)(abuf + s * 128 + cq * 8) = v; }
    __syncthreads();
    {
        const int wnd = 2 << gi, c = tid & 127, t0 = (tid >> 7) * 32; float sum = 0.f;
        for (int s = t0 - wnd + 1; s < t0; ++s) sum += bf2f(abuf[(s + 15) * 128 + c]);
        const float inv = 1.f / (float)wnd;
        for (int t = t0; t < t0 + 32; ++t) {
            const float at = bf2f(abuf[(t + 15) * 128 + c]); sum += at;
            float mean = sum * inv; if (first && t + 1 < wnd) mean = sum / (float)(t + 1);
            pbuf[t * PSTR + c] = f2bf(mean - at);
            sum -= bf2f(abuf[(t + 16 - wnd) * 128 + c]);
        }
    }
    __syncthreads();
    {
        const int fr = lane & 15, fq = lane >> 4; bf16x8 wf[4];
#pragma unroll
        for (int ks = 0; ks < 4; ++ks) wf[ks] = *(const bf16x8*)(WPT + (size_t)gi * 16384 + (16 * wave + fr) * 128 + 32 * ks + 8 * fq);
        const f32x4 sp = *(const f32x4*)(s_pool + gi * 128 + 16 * wave + 4 * fq);
#pragma unroll
        for (int tt = 0; tt < 8; ++tt) {
            f32x4 acc = (f32x4){0.f, 0.f, 0.f, 0.f};
#pragma unroll
            for (int ks = 0; ks < 4; ++ks) { const bf16x8 pf = *(const LAS bf16x8*)(pbuf + (16 * tt + fr) * PSTR + 32 * ks + 8 * fq); acc = __builtin_amdgcn_mfma_f32_16x16x32_bf16(wf[ks], pf, acc, 0, 0, 0); }
            acc = acc * sp; u32x2 w; w.x = cvt_pk_bf16(acc[0], acc[1]); w.y = cvt_pk_bf16(acc[2], acc[3]);
            *(u32x2*)(pa + (size_t)(m0 + 16 * tt + fr) * PW + gi * 128 + 16 * wave + 4 * fq) = w;
        }
    }
    __syncthreads();
}
__device__ __forceinline__ void p2_gate_unit(LAS unsigned char* lds, int ch, int g, const bf16_t* zu, const bf16_t* zv, const float* vssq, const bf16_t* WST, const float* g_v, const float* b_s, bf16_t* sg,
                                             int tid, int wave, int lane) {
    LAS bf16_t* vT = (LAS bf16_t*)lds;
    LAS float* rbuf = (LAS float*)(lds + 40960);
    const int m0 = ch * 128;
    if (tid < 128) { const f32x4* sp = (const f32x4*)(vssq + (size_t)(m0 + tid) * 8); const f32x4 s4 = sp[0] + sp[1]; rbuf[tid] = rsqrtf(((s4[0] + s4[1]) + (s4[2] + s4[3])) * (1.f / GWID) + EPS); }
    __syncthreads();
#pragma unroll
    for (int it = 0; it < 4; ++it) {
        const int j = tid >> 2, chunk = (tid & 3) + 4 * it;
        const u32x4 raw = *(const u32x4*)(zv + (size_t)(m0 + j) * GWID + g * 128 + chunk * 8); const float r = rbuf[j];
        const float v8[8] = {bf_lo(raw.x), bf_hi(raw.x), bf_lo(raw.y), bf_hi(raw.y), bf_lo(raw.z), bf_hi(raw.z), bf_lo(raw.w), bf_hi(raw.w)};
#pragma unroll
        for (int i = 0; i < 8; ++i) vT[(chunk * 8 + i) * PSTR + j] = f2bf(v8[i] * r);
    }
    __syncthreads();
    {
        const int fr = lane & 15, fq = lane >> 4; bf16x8 wf[4];
#pragma unroll
        for (int ks = 0; ks < 4; ++ks) wf[ks] = *(const bf16x8*)(WST + (size_t)g * 16384 + (16 * wave + fr) * 128 + 32 * ks + 8 * fq);
        const int i = 16 * wave + fr; const float bias = b_s[g * 128 + i];
#pragma unroll
        for (int ct = 0; ct < 8; ++ct) {
            f32x4 acc = (f32x4){0.f, 0.f, 0.f, 0.f};
#pragma unroll
            for (int ks = 0; ks < 4; ++ks) { const bf16x8 vf = *(const LAS bf16x8*)(vT + (16 * ct + fr) * PSTR + 32 * ks + 8 * fq); acc = __builtin_amdgcn_mfma_f32_16x16x32_bf16(vf, wf[ks], acc, 0, 0, 0); }
            const int c = g * 128 + 16 * ct + 4 * fq; const f32x4 gv = *(const f32x4*)(g_v + c);
            const u32x2 uu = *(const u32x2*)(zu + (size_t)(m0 + i) * GWID + c);
            const f32x4 s = acc * gv + bias; u32x2 w; w.x = cvt_pk_bf16(bf_lo(uu.x) * s[0], bf_hi(uu.x) * s[1]); w.y = cvt_pk_bf16(bf_lo(uu.y) * s[2], bf_hi(uu.y) * s[3]);
            *(u32x2*)(sg + (size_t)(m0 + i) * GWID + c) = w;
        }
    }
    __syncthreads();
}

__global__ void __launch_bounds__(NWAVES * 64, 2) fwd_kernel(Args args) {
    extern __shared__ __attribute__((aligned(16))) unsigned char lds_raw[];
    LAS unsigned char* lds = (LAS unsigned char*)lds_raw;
    volatile LAS unsigned* MISC = (volatile LAS unsigned*)(lds + MISC_OFF);
    const int tid = threadIdx.x, lane = tid & 63, wave = __builtin_amdgcn_readfirstlane(tid >> 6);
    const int G = gridDim.x, cu = blockIdx.x;
    unsigned char* ws = args.ws; float* out = args.out;
    for (int u = tid; u < (LDS_BYTES - LDSCTL_OFF) / 4; u += NWAVES * 64) ((LAS unsigned*)(lds + LDSCTL_OFF))[u] = 0u;
    __syncthreads();
    XcdBarrier bar; bar.bar = (unsigned*)(ws + WS_CTL) + CW_BAR + args.li * XCD_BAR_WORDS; bar.x = 0; bar.st = nullptr;
    if (MK_N_LAUNCHES == 1) bar = xcd_barrier_post((unsigned*)(ws + WS_CTL) + CW_BAR + args.li * XCD_BAR_WORDS, MISC + 8);
    const int lo = args.ph_lo, hi = args.ph_hi;
#define IN(k) (lo <= (k) && (k) < hi)
#define SEAM(k) do { if (IN(k) && IN((k) + 1)) xcd_barrier(bar); } while (0)

    bf16_t* WIN = (bf16_t*)(ws + WS_WIN); bf16_t* WGO = (bf16_t*)(ws + WS_WGO); bf16_t* WPO = (bf16_t*)(ws + WS_WPO); bf16_t* WOUT = (bf16_t*)(ws + WS_WOUT);
    bf16_t* WGU = (bf16_t*)(ws + WS_WGU); bf16_t* WD = (bf16_t*)(ws + WS_WD); bf16_t* WPT = (bf16_t*)(ws + WS_WPT); bf16_t* WST = (bf16_t*)(ws + WS_WST);
    float* VSSQ = (float*)(ws + WS_VSSQ); float* XSSQ = (float*)(ws + WS_XSSQ);
    bf16_t* H = (bf16_t*)(ws + WS_H); bf16_t* MERGED = (bf16_t*)(ws + WS_MERGED); bf16_t* ABUF = (bf16_t*)(ws + WS_A); bf16_t* ZU = (bf16_t*)(ws + WS_ZU); bf16_t* X1B = (bf16_t*)(ws + WS_X1B);
    bf16_t* ZV = (bf16_t*)(ws + WS_ZV); bf16_t* GA = (bf16_t*)(ws + WS_GA); bf16_t* GB = (bf16_t*)(ws + WS_GB); bf16_t* ACT = (bf16_t*)(ws + WS_ACT);
    bf16_t* PA = (bf16_t*)(ws + WS_PA); bf16_t* SG = (bf16_t*)(ws + WS_SG);
    bf16_t* HS = (bf16_t*)(ws + WS_HS); float* PROJS = (float*)(ws + WS_PROJS); bf16_t* PS = (bf16_t*)(ws + WS_PS); bf16_t* PAS = (bf16_t*)(ws + WS_PAS); bf16_t* SGS = (bf16_t*)(ws + WS_SGS);
    bf16_t* MERGEDS = (bf16_t*)(ws + WS_MERGEDS); bf16_t* X1SB = (bf16_t*)(ws + WS_X1SB); float* SSQS = (float*)(ws + WS_SSQS); bf16_t* ACTS = (bf16_t*)(ws + WS_ACTS);
    LAS float* red = (LAS float*)lds;

    if (IN(0)) {
        LAS float* scr = (LAS float*)(lds + wave * 16384);
        const int gw = cu * NWAVES + wave, NGW = G * NWAVES;
        constexpr int I_IN = 16 * 112, I_GO = 8 * 32, I_PO = 8 * 32, I_OUT = 16 * 32, I_G = 16 * 88, I_U = 16 * 88, I_D = 44 * 32, I_P = 4 * 8;
        constexpr int NITEMS = I_IN + I_GO + I_PO + I_OUT + I_G + I_U + I_D + I_P;
        for (int it = gw; it < NITEMS; it += NGW) {
            int r = it;
            if (r < I_IN) { const int kb = r / 112, nb = r % 112; tr_item(args.in[I_WIN], INW, WIN, D, scr, 64 * kb, 32 * nb, 32 * nb, lane, nullptr); continue; } r -= I_IN;
            if (r < I_GO) { const int kb = r / 32, nb = r % 32; tr_item(args.in[I_WGO], D, WGO, 512, scr, 64 * kb, 32 * nb, 32 * nb, lane, nullptr); continue; } r -= I_GO;
            if (r < I_PO) { const int kb = r / 32, nb = r % 32; tr_item(args.in[I_WPO], D, WPO, 512, scr, 64 * kb, 32 * nb, 32 * nb, lane, nullptr); continue; } r -= I_PO;
            if (r < I_OUT) { const int kb = r / 32, nb = r % 32; tr_item(args.in[I_WOUT], D, WOUT, D, scr, 64 * kb, 32 * nb, 32 * nb, lane, nullptr); continue; } r -= I_OUT;
            if (r < I_G) { const int kb = r / 88, nb = r % 88, n0 = 32 * nb; tr_item(args.in[I_WG], DFF, WGU, D, scr, 64 * kb, n0, (n0 >> 7) * 256 + (n0 & 127), lane, args.in[I_GFFN]); continue; } r -= I_G;
            if (r < I_U) { const int kb = r / 88, nb = r % 88, n0 = 32 * nb; tr_item(args.in[I_WU], DFF, WGU, D, scr, 64 * kb, n0, (n0 >> 7) * 256 + 128 + (n0 & 127), lane, args.in[I_GFFN]); continue; } r -= I_U;
            if (r < I_D) { const int kb = r / 32, nb = r % 32; tr_item(args.in[I_WD], D, WD, DFF, scr, 64 * kb, 32 * nb, 32 * nb, lane, nullptr); continue; } r -= I_D;
            { const int g = r >> 3, kb = (r >> 2) & 1, nb = r & 3; tr_item(args.in[I_WPOOL] + (size_t)g * 16384, 128, WPT + (size_t)g * 16384, 128, scr, 64 * kb, 32 * nb, 32 * nb, lane, nullptr); }
        }
        for (int it = gw; it < 1024; it += NGW) { const int e = it * 64 + lane, i = (e >> 7) & 127, j = e & 127; WST[e] = (j <= i) ? f2bf(args.in[I_WS][e]) : (bf16_t)0; }
        for (int m = gw; m < M + NS; m += NGW) {
            if (m < M) norm_row_bf16(args.in[I_XP] + (size_t)m * D, args.in[I_GMIX], H + (size_t)m * D, lane);
            else norm_row_bf16(args.in[I_XS] + (size_t)(m - M) * D, args.in[I_GMIX], HS + (size_t)(m - M) * D, lane);
        }
        {
            const f32x4* src = (const f32x4*)args.in[I_STATE]; f32x4* dst = (f32x4*)(out + O_PS);
            for (int idx = cu * (NWAVES * 64) + tid; idx < NS * 1792; idx += G * NWAVES * 64) { const int b = idx / 1792, rem = idx - b * 1792; dst[b * 1920 + rem] = src[b * 1920 + 128 + rem]; }
        }
        __syncthreads();
    }
    SEAM(0);

    if (IN(1)) {
        pg8::Gemm g{H, H, WIN, WIN, D}; pg8::StaticOrder S; S.init(M, INW, G, cu, 1);
        pg8::EpiProj E{ABUF, ZU, ZV, GA, GB, VSSQ, out + O_PP};
        pg8::gemm_phase<pg8::EpiProj, true>(lds, g, S, E);
        const int half = G / 2;
        if (cu >= half) for (int t = cu - half; t < 4 * 224; t += G - half) {
            const int rt = t & 3, ct = t >> 2; f32x4 a0 = (f32x4){0.f, 0.f, 0.f, 0.f}, a1 = a0;
            const int row = rt * 32 + (tid >> 4), col = ct * 16 + (tid & 15);
            float st = 0.f; const int wnd = 2 << (ct >> 3);
            if (ct < 32) {
                const float* sp = args.in[I_STATE] + (size_t)row * PST * PW + col;
#pragma unroll
                for (int s2 = 0; s2 < 15; ++s2) st += (s2 >= 16 - wnd ? 1.f : 0.f) * sp[s2 * PW];
            }
            mini_acc<4>(a0, a1, HS + (size_t)rt * 32 * D, D, WIN + (size_t)ct * 16 * D, D, wave, lane);
            float v = mini_reduce(red, a0, a1, tid, wave, lane);
            if (col < 512) { out[O_PS + ((size_t)row * PST + 14) * PW + col] = v; PS[(size_t)row * PW + col] = f2bf((st + v) / (float)wnd - v); }
            else if (col < 1536) v = gelu_f(v);
            else v = sigmoid_f(v);
            PROJS[(size_t)row * INW + col] = v;
        }
    }
    SEAM(1);

    if (IN(2)) {
        for (int u = cu; u < 1024; u += G) {
            const int ch = (u >> 1) & 127, type = u & 1, grp = u >> 8;
            if (type == 0) p2_pool_unit(lds, ch, grp, ABUF, WPT, args.in[I_SPOOL], PA, tid, wave, lane);
            else p2_gate_unit(lds, ch, grp, ZU, ZV, VSSQ, WST, args.in[I_GV], args.in[I_BS], SG, tid, wave, lane);
        }
        if (cu < 8) {
            for (int q = 0; q < 2; ++q) {
                const int b = cu * 16 + 2 * wave + q; float zvv[8]; float ss = 0.f;
#pragma unroll
                for (int j = 0; j < 8; ++j) { zvv[j] = PROJS[(size_t)b * INW + 1024 + lane + 64 * j]; ss += zvv[j] * zvv[j]; }
                const float r = rsqrtf(wave_sum(ss) * (1.f / GWID) + EPS);
#pragma unroll
                for (int j = 0; j < 8; ++j) {
                    const int col = lane + 64 * j, gi = col >> 7;
                    const float v = zvv[j] * r * args.in[I_GV][col];
                    out[O_VS + (size_t)b * GWID + col] = v;
                    const float s = args.in[I_WS][(size_t)gi * 16384] * v + args.in[I_BS][gi * 128];
                    SGS[(size_t)b * GWID + col] = f2bf(PROJS[(size_t)b * INW + 512 + col] * s);
                }
            }
            const int fr = lane & 15, fq = lane >> 4;
#pragma unroll
            for (int q = 0; q < 4; ++q) {
                const int d0 = 16 * (4 * wave + q), g = d0 >> 7, dl = d0 & 127; f32x4 acc = (f32x4){0.f, 0.f, 0.f, 0.f};
#pragma unroll
                for (int ks = 0; ks < 4; ++ks) {
                    const bf16x8 wf = *(const bf16x8*)(WPT + (size_t)g * 16384 + (dl + fr) * 128 + 32 * ks + 8 * fq);
                    const bf16x8 pf = *(const bf16x8*)(PS + (size_t)(cu * 16 + fr) * PW + g * 128 + 32 * ks + 8 * fq);
                    acc = __builtin_amdgcn_mfma_f32_16x16x32_bf16(wf, pf, acc, 0, 0, 0);
                }
                const f32x4 sp = *(const f32x4*)(args.in[I_SPOOL] + d0 + 4 * fq); acc = acc * sp;
                u32x2 w; w.x = cvt_pk_bf16(acc[0], acc[1]); w.y = cvt_pk_bf16(acc[2], acc[3]);
                *(u32x2*)(PAS + (size_t)(cu * 16 + fr) * PW + d0 + 4 * fq) = w;
            }
        }
    }
    SEAM(2);

    if (IN(3)) {
        pg8::Gemm g{SG, PA, WGO, WPO, 512}; pg8::StaticOrder S; S.init(M, D, G, cu, 2);
        pg8::EpiMerge E{GA, GB, MERGED};
        pg8::gemm_phase<pg8::EpiMerge, true>(lds, g, S, E);
        for (int t = cu; t < 256; t += G) {
            const int rt = t & 3, ct = t >> 2; f32x4 p0 = (f32x4){0.f, 0.f, 0.f, 0.f}, p1 = p0, q0 = p0, q1 = p0;
            mini_acc<2>(p0, p1, PAS + (size_t)rt * 32 * PW, PW, WPO + (size_t)ct * 16 * 512, 512, wave, lane);
            mini_acc<2>(q0, q1, SGS + (size_t)rt * 32 * GWID, GWID, WGO + (size_t)ct * 16 * 512, 512, wave, lane);
            const float vp = mini_reduce(red, p0, p1, tid, wave, lane), vg = mini_reduce(red + 4096, q0, q1, tid, wave, lane);
            const int row = rt * 32 + (tid >> 4), col = ct * 16 + (tid & 15);
            MERGEDS[(size_t)row * D + col] = f2bf(PROJS[(size_t)row * INW + 1536 + col] * vp + PROJS[(size_t)row * INW + 2560 + col] * vg);
        }
    }
    SEAM(3);

    if (IN(4)) {
        pg8::Gemm g{MERGED, MERGED, WOUT, WOUT, D}; pg8::StaticOrder S; S.init(M, D, G, cu, 1);
        pg8::EpiWout E{args.in[I_XP], out + O_YP, X1B, XSSQ};
        pg8::gemm_phase<pg8::EpiWout, false>(lds, g, S, E);
        for (int t = cu; t < 256; t += G) {
            const int rt = t & 3, ct = t >> 2; f32x4 a0 = (f32x4){0.f, 0.f, 0.f, 0.f}, a1 = a0;
            mini_acc<4>(a0, a1, MERGEDS + (size_t)rt * 32 * D, D, WOUT + (size_t)ct * 16 * D, D, wave, lane);
            const int row = rt * 32 + (tid >> 4), col = ct * 16 + (tid & 15);
            const float v = mini_reduce(red, a0, a1, tid, wave, lane) + args.in[I_XS][(size_t)row * D + col];
            out[O_YS + (size_t)row * D + col] = v; X1SB[(size_t)row * D + col] = f2bf(v);
            float ss = v * v; ss += __shfl_xor(ss, 1); ss += __shfl_xor(ss, 2); ss += __shfl_xor(ss, 4); ss += __shfl_xor(ss, 8);
            if ((tid & 15) == 0) SSQS[(size_t)row * 64 + ct] = ss;
        }
    }
    SEAM(4);

    if (IN(5)) {
        pg8::Gemm g{X1B, X1B, WGU, WGU, D}; pg8::StaticOrder S; S.init(M, 2 * DFF, G, cu, 1);
        pg8::EpiGU E{XSSQ, ACT};
        pg8::gemm_phase<pg8::EpiGU, true>(lds, g, S, E);
        const int half = G / 2;
        if (cu >= half) for (int t = cu - half; t < 4 * 176; t += G - half) {
            const int rt = t & 3, ct = t >> 2, p = ct >> 3, j0 = (ct & 7) * 16; f32x4 g0 = (f32x4){0.f, 0.f, 0.f, 0.f}, g1 = g0, u0 = g0, u1 = g0;
            mini_acc<4>(g0, g1, X1SB + (size_t)rt * 32 * D, D, WGU + (size_t)(256 * p + j0) * D, D, wave, lane);
            mini_acc<4>(u0, u1, X1SB + (size_t)rt * 32 * D, D, WGU + (size_t)(256 * p + 128 + j0) * D, D, wave, lane);
            const float vg = mini_reduce(red, g0, g1, tid, wave, lane), vu = mini_reduce(red + 4096, u0, u1, tid, wave, lane);
            const int row = rt * 32 + (tid >> 4), col = tid & 15;
            const f32x4 s4 = *(const f32x4*)(SSQS + (size_t)row * 64 + 4 * col); float ss = (s4[0] + s4[1]) + (s4[2] + s4[3]);
            ss += __shfl_xor(ss, 1); ss += __shfl_xor(ss, 2); ss += __shfl_xor(ss, 4); ss += __shfl_xor(ss, 8);
            const float r = rsqrtf(ss * (1.f / D) + EPS), gg = vg * r;
            ACTS[(size_t)row * DFF + ct * 16 + col] = f2bf(gg * sigmoid_f(gg) * (vu * r));
        }
    }
    SEAM(5);

    if (IN(6)) {
        pg8::Gemm g{ACT, ACT, WD, WD, DFF}; pg8::StaticOrder S; S.init(M, D, G, cu, 1);
        pg8::EpiDown E{out + O_YP};
        pg8::gemm_phase<pg8::EpiDown, false>(lds, g, S, E);
        for (int t = cu; t < 256; t += G) {
            const int rt = t & 3, ct = t >> 2; f32x4 a0 = (f32x4){0.f, 0.f, 0.f, 0.f}, a1 = a0;
            mini_acc<11>(a0, a1, ACTS + (size_t)rt * 32 * DFF, DFF, WD + (size_t)ct * 16 * DFF, DFF, wave, lane);
            const int row = rt * 32 + (tid >> 4), col = ct * 16 + (tid & 15);
            out[O_YS + (size_t)row * D + col] += mini_reduce(red, a0, a1, tid, wave, lane);
        }
    }
    SEAM(6);

    if (IN(7)) {
        const int gw = cu * NWAVES + wave, NGW = G * NWAVES; const f32x4* gr = (const f32x4*)args.in[I_GFINAL] + lane;
        for (int m = gw; m < M + NS; m += NGW) {
            f32x4* xr = (f32x4*)(out + (size_t)m * D) + lane; f32x4 v[4]; float s = 0.f;
#pragma unroll
            for (int j = 0; j < 4; ++j) { v[j] = xr[64 * j]; s += (v[j][0] * v[j][0] + v[j][1] * v[j][1]) + (v[j][2] * v[j][2] + v[j][3] * v[j][3]); }
            const float r = rsqrtf(wave_sum(s) * (1.f / D) + EPS);
#pragma unroll
            for (int j = 0; j < 4; ++j) xr[64 * j] = v[j] * r * gr[64 * j];
        }
    }
#undef IN
#undef SEAM
}

extern "C" void kernel_launch(void* const* d_in, const int* in_sizes, int n_in, void* d_out, int out_size, void* d_ws, size_t ws_size, hipStream_t stream) {
    static int grid = 0;
    if (grid == 0) {
        if (n_in != 18 || ws_size < WS_END) { fprintf(stderr, "kernel_launch: built for 18 inputs and >= %zu bytes of workspace; got n_in %d, ws %zu\n", (size_t)WS_END, n_in, ws_size); grid = -1; return; }
        int dev = 0, cus = 0, per_cu = 0;
        if (hipGetDevice(&dev) != hipSuccess || hipDeviceGetAttribute(&cus, hipDeviceAttributeMultiprocessorCount, dev) != hipSuccess) { fprintf(stderr, "kernel_launch: device query failed\n"); grid = -1; return; }
        if (hipFuncSetAttribute((const void*)fwd_kernel, hipFuncAttributeMaxDynamicSharedMemorySize, LDS_BYTES) != hipSuccess) { fprintf(stderr, "kernel_launch: hipFuncSetAttribute failed\n"); grid = -1; return; }
        if (hipOccupancyMaxActiveBlocksPerMultiprocessor(&per_cu, (const void*)fwd_kernel, NWAVES * 64, LDS_BYTES) != hipSuccess || per_cu < 1)
            fprintf(stderr, "kernel_launch: occupancy query reports %d workgroups per CU\n", per_cu);
        (void)hipGetLastError();
        grid = cus;
    }
    if (grid < 0) return;
    (void)hipMemsetAsync((char*)d_ws + WS_CTL, 0, CTL_ZERO_BYTES, stream);
    Args a{};
    for (int i = 0; i < 18; ++i) a.in[i] = (const float*)d_in[i];
    a.out = (float*)d_out; a.ws = (unsigned char*)d_ws;
    if (PROBE_REPEAT_PHASE >= 0) {
        a.ph_lo = 0; a.ph_hi = PROBE_REPEAT_PHASE + 1; a.li = 0; hipLaunchKernelGGL(fwd_kernel, dim3(grid), dim3(NWAVES * 64), LDS_BYTES, stream, a);
        a.ph_lo = PROBE_REPEAT_PHASE; a.ph_hi = 8; a.li = 1; hipLaunchKernelGGL(fwd_kernel, dim3(grid), dim3(NWAVES * 64), LDS_BYTES, stream, a);
    } else if (MK_N_LAUNCHES == 1) { a.ph_lo = 0; a.ph_hi = 8; hipLaunchKernelGGL(fwd_kernel, dim3(grid), dim3(NWAVES * 64), LDS_BYTES, stream, a); }
    else for (int li = 0; li < 8; ++li) { a.ph_lo = li; a.ph_hi = li + 1; hipLaunchKernelGGL(fwd_kernel, dim3(grid), dim3(NWAVES * 64), LDS_BYTES, stream, a); }
    const hipError_t le = hipPeekAtLastError();
    if (le != hipSuccess) fprintf(stderr, "kernel_launch: launch failed: %s\n", hipGetErrorName(le));
}
```
